# Optimizing an MI355X kernel written in HIP

```python
import jax, jax.numpy as jnp
from jax import lax
import numpy as np

D_MODEL = 2048
BATCH = 4
SEQ = 4096
DEPTH = 4

N_MEM = 256
N_MIXERS = 3
HEAD_DIM = 128
BLOCK = 128
NORM_EPS = 1e-6
ROPE_THETA = 500000.0
ROPE_FRACTION = 4
SB_HEADS = D_MODEL // HEAD_DIM
DIL_PATTERNS = ((128, 1), (512, 4), (2048, 16))
DIL_HEADS_PER_GROUP = D_MODEL // (4 * HEAD_DIM)
DIL_HEADS = DIL_HEADS_PER_GROUP * len(DIL_PATTERNS)
SWA_HEAD_DIM = 64
SWA_Q_HEADS = D_MODEL // SWA_HEAD_DIM
SWA_KV_HEADS = SWA_Q_HEADS // 8
SWA_GROUP = SWA_Q_HEADS // SWA_KV_HEADS
SWA_WINDOW = 128
XA_HEADS = 4
XA_HEAD_DIM = 128
D_FF = 5632
N_LAYERS_A = (DEPTH + 2) // 3
N_LAYERS_B = (DEPTH + 1) // 3
N_LAYERS_C = DEPTH // 3

kernel_name = "hybrid_sb_dilated_swa_macaron"

F32 = jnp.float32


def rmsnorm(x, g):
    xf = x.astype(F32)
    y = xf * lax.rsqrt(jnp.mean(xf * xf, axis=-1, keepdims=True) + NORM_EPS)
    return (y * g.astype(F32)).astype(x.dtype)


def swiglu(x, w_gate_up, w_down):
    gate, up = jnp.split(x @ w_gate_up, 2, axis=-1)
    return (jax.nn.silu(gate) * up) @ w_down


def partial_rotary(x, positions):
    d = x.shape[-1]
    rot = d // ROPE_FRACTION
    half = rot // 2
    inv_freq = jnp.power(F32(ROPE_THETA), -jnp.arange(half, dtype=F32) * 2.0 / rot)
    ang = positions.astype(F32)[..., None] * inv_freq
    cos = jnp.cos(ang)[:, :, None, :]
    sin = jnp.sin(ang)[:, :, None, :]
    xf = x.astype(F32)
    x1, x2, rest = xf[..., :half], xf[..., half:rot], xf[..., rot:]
    out = jnp.concatenate([x1 * cos - x2 * sin, x2 * cos + x1 * sin, rest], axis=-1)
    return out.astype(x.dtype)


def banded_window_attention(q, k, v, max_dist, sinks=None):
    n, L, hk, g, d = q.shape
    nb = L // BLOCK
    qb = q.reshape(n, nb, BLOCK, hk, g, d)

    def with_prev(t):
        t = t.reshape(n, nb, BLOCK, hk, d)
        prev = jnp.pad(t, ((0, 0), (1, 0), (0, 0), (0, 0), (0, 0)))[:, :-1]
        return jnp.concatenate([prev, t], axis=2)

    kk, vv = with_prev(k), with_prev(v)
    scores = jnp.einsum('bnqhgd,bnkhd->bnhgqk', qb, kk, preferred_element_type=F32) * (d ** -0.5)
    dist = (BLOCK + jnp.arange(BLOCK))[:, None] - jnp.arange(2 * BLOCK)[None, :]
    in_band = (dist >= 0) & (dist <= max_dist)
    has_prev = (jnp.arange(nb)[:, None] > 0) | (jnp.arange(2 * BLOCK)[None, :] >= BLOCK)
    mask = in_band[None] & has_prev[:, None, :]
    scores = jnp.where(mask[None, :, None, None], scores, -jnp.inf)
    lse = jax.nn.logsumexp(scores, axis=-1)
    if sinks is not None:
        lse = jnp.logaddexp(lse, sinks.astype(F32)[None, None, :, :, None])
    p = jnp.exp(scores - lse[..., None])
    o = jnp.einsum('bnhgqk,bnkhd->bnqhgd', p, vv.astype(F32)).astype(q.dtype)
    return o.reshape(n, L, hk, g, d), lse.transpose(0, 1, 4, 2, 3).reshape(n, L, hk, g)


def stick_breaking_attention(q, k, v):
    b, s, h, d = q.shape
    nb = s // BLOCK
    qb = q.reshape(b, nb, BLOCK, h, d).transpose(1, 0, 2, 3, 4)
    kpos = jnp.arange(s)
    vf = v.astype(F32)

    def block_fn(args):
        q_blk, blk = args
        z = jnp.einsum('bqhd,bkhd->bhqk', q_blk, k, preferred_element_type=F32) * (d ** -0.5)
        qpos = blk * BLOCK + jnp.arange(BLOCK)
        causal = kpos[None, :] < qpos[:, None]
        log_keep = jnp.where(causal, -jax.nn.softplus(z), 0.0)
        tail = lax.cumsum(log_keep, axis=3, reverse=True) - log_keep
        a = jnp.where(causal, jnp.exp(jax.nn.log_sigmoid(z) + tail), 0.0)
        return jnp.einsum('bhqk,bkhd->bqhd', a, vf).astype(q.dtype)

    out = lax.map(block_fn, (qb, jnp.arange(nb, dtype=jnp.int32)))
    return out.transpose(1, 0, 2, 3, 4).reshape(b, s, h, d)


def stick_breaking_mixer(h, w_qkv, w_o):
    b, s, _ = h.shape
    qkv = (h @ w_qkv).reshape(b, s, 3, SB_HEADS, HEAD_DIM)
    o = stick_breaking_attention(qkv[:, :, 0], qkv[:, :, 1], qkv[:, :, 2])
    return o.reshape(b, s, SB_HEADS * HEAD_DIM) @ w_o


def dilated_group_attention(q, k, v, window, dil):
    b, s, h, d = q.shape
    L = s // dil
    Lp = -(-L // BLOCK) * BLOCK

    def to_classes(t):
        t = t.reshape(b, L, dil, h, d).transpose(0, 2, 1, 3, 4).reshape(b * dil, L, h, d)
        return jnp.pad(t, ((0, 0), (0, Lp - L), (0, 0), (0, 0)))

    qc, kc, vc = to_classes(q), to_classes(k), to_classes(v)
    o, lse = banded_window_attention(qc[:, :, :, None], kc, vc, window // dil)
    o = o[:, :L, :, 0].reshape(b, dil, L, h, d).transpose(0, 2, 1, 3, 4).reshape(b, s, h, d)
    lse = lse[:, :L, :, 0].reshape(b, dil, L, h).transpose(0, 2, 1, 3).reshape(b, s, h)
    return o, lse


def dilated_mixer(h, positions, w_qkv, w_o):
    b, s, _ = h.shape
    hg = DIL_HEADS_PER_GROUP
    qkv = (h @ w_qkv).reshape(b, s, 3, DIL_HEADS, HEAD_DIM)
    q = partial_rotary(qkv[:, :, 0], positions)
    k = partial_rotary(qkv[:, :, 1], positions)
    v = qkv[:, :, 2]
    outs, lses = [], []
    for g, (window, dil) in enumerate(DIL_PATTERNS):
        sl = slice(g * hg, (g + 1) * hg)
        o, lse = dilated_group_attention(q[:, :, sl], k[:, :, sl], v[:, :, sl], window, dil)
        outs.append(o)
        lses.append(lse)
    alpha = jax.nn.softmax(jnp.stack(lses, axis=0), axis=0)
    out = jnp.concatenate(
        [(o.astype(F32) * a[..., None]).astype(h.dtype) for o, a in zip(outs, alpha)], axis=2)
    return out.reshape(b, s, DIL_HEADS * HEAD_DIM) @ w_o


def swa_sink_mixer(h, positions, w_qkv, b_qkv, sinks, w_o, b_o):
    b, s, _ = h.shape
    nq = SWA_Q_HEADS * SWA_HEAD_DIM
    nk = SWA_KV_HEADS * SWA_HEAD_DIM
    qkv = h @ w_qkv + b_qkv
    q = partial_rotary(qkv[..., :nq].reshape(b, s, SWA_Q_HEADS, SWA_HEAD_DIM), positions)
    q = q.reshape(b, s, SWA_KV_HEADS, SWA_GROUP, SWA_HEAD_DIM)
    k = partial_rotary(qkv[..., nq:nq + nk].reshape(b, s, SWA_KV_HEADS, SWA_HEAD_DIM), positions)
    v = qkv[..., nq + nk:].reshape(b, s, SWA_KV_HEADS, SWA_HEAD_DIM)
    o, _ = banded_window_attention(q, k, v, SWA_WINDOW - 1, sinks.reshape(SWA_KV_HEADS, SWA_GROUP))
    return o.reshape(b, s, nq) @ w_o + b_o


def memory_cross_attention(h, mem_h, w_q, w_kv, w_o):
    b, s, _ = h.shape
    m = mem_h.shape[1]
    q = (h @ w_q).reshape(b, s, XA_HEADS, XA_HEAD_DIM)
    kv = (mem_h @ w_kv).reshape(b, m, 2, XA_HEADS, XA_HEAD_DIM)
    scores = jnp.einsum('bqhd,bkhd->bhqk', q, kv[:, :, 0], preferred_element_type=F32) * (XA_HEAD_DIM ** -0.5)
    p = jax.nn.softmax(scores, axis=-1)
    o = jnp.einsum('bhqk,bkhd->bqhd', p, kv[:, :, 1].astype(F32)).astype(h.dtype)
    return o.reshape(b, s, XA_HEADS * XA_HEAD_DIM) @ w_o


def setup_inputs(seed: int = 0) -> dict:
    key = jax.random.key(seed)
    ks = iter(jax.random.split(key, 32))
    D, F = D_MODEL, D_FF

    def normal(shape, scale):
        return jax.random.normal(next(ks), shape, F32) * scale

    def dense(shape, fan_in):
        return normal(shape, fan_in ** -0.5)

    def gain(shape):
        return 1.0 + normal(shape, 0.02)

    sb_w = SB_HEADS * HEAD_DIM
    dil_w = DIL_HEADS * HEAD_DIM
    swa_q = SWA_Q_HEADS * SWA_HEAD_DIM
    swa_qkv = swa_q + 2 * SWA_KV_HEADS * SWA_HEAD_DIM
    xa_w = XA_HEADS * XA_HEAD_DIM
    return {
        "x": normal((BATCH, SEQ, D), 1.0),
        "mem": normal((BATCH, N_MEM, D), 1.0),
        "positions": (jax.random.randint(next(ks), (BATCH, 1), 0, 1024, dtype=jnp.int32)
                      + jnp.arange(SEQ, dtype=jnp.int32)[None, :]),
        "ffn1_norm": gain((DEPTH, D)),
        "ffn1_w_gate_up": dense((DEPTH, D, 2 * F), D),
        "ffn1_w_down": dense((DEPTH, F, D), F),
        "mix_norm": gain((DEPTH, D)),
        "sb_w_qkv": dense((N_LAYERS_A, D, 3 * sb_w), D),
        "sb_w_o": dense((N_LAYERS_A, sb_w, D), sb_w),
        "dil_w_qkv": dense((N_LAYERS_B, D, 3 * dil_w), D),
        "dil_w_o": dense((N_LAYERS_B, dil_w, D), dil_w),
        "swa_w_qkv": dense((N_LAYERS_C, D, swa_qkv), D),
        "swa_b_qkv": normal((N_LAYERS_C, swa_qkv), 0.02),
        "swa_sinks": normal((N_LAYERS_C, SWA_Q_HEADS), 1.0),
        "swa_w_o": dense((N_LAYERS_C, swa_q, D), swa_q),
        "swa_b_o": normal((N_LAYERS_C, D), 0.02),
        "xattn_norm": gain((DEPTH, D)),
        "mem_norm": gain((DEPTH, D)),
        "xattn_w_q": dense((DEPTH, D, xa_w), D),
        "xattn_w_kv": dense((DEPTH, D, 2 * xa_w), D),
        "xattn_w_o": dense((DEPTH, xa_w, D), xa_w),
        "ffn2_norm": gain((DEPTH, D)),
        "ffn2_w_gate_up": dense((DEPTH, D, 2 * F), D),
        "ffn2_w_down": dense((DEPTH, F, D), F),
        "final_norm": gain((D,)),
    }


def reference(x, mem, positions, ffn1_norm, ffn1_w_gate_up, ffn1_w_down, mix_norm,
              sb_w_qkv, sb_w_o, dil_w_qkv, dil_w_o,
              swa_w_qkv, swa_b_qkv, swa_sinks, swa_w_o, swa_b_o,
              xattn_norm, mem_norm, xattn_w_q, xattn_w_kv, xattn_w_o,
              ffn2_norm, ffn2_w_gate_up, ffn2_w_down, final_norm):
    for i in range(DEPTH):
        x = x + 0.5 * swiglu(rmsnorm(x, ffn1_norm[i]), ffn1_w_gate_up[i], ffn1_w_down[i])
        h = rmsnorm(x, mix_norm[i])
        kind, j = i % N_MIXERS, i // N_MIXERS
        if kind == 0:
            y = stick_breaking_mixer(h, sb_w_qkv[j], sb_w_o[j])
        elif kind == 1:
            y = dilated_mixer(h, positions, dil_w_qkv[j], dil_w_o[j])
        else:
            y = swa_sink_mixer(h, positions, swa_w_qkv[j], swa_b_qkv[j], swa_sinks[j],
                               swa_w_o[j], swa_b_o[j])
        x = x + y
        x = x + memory_cross_attention(rmsnorm(x, xattn_norm[i]), rmsnorm(mem, mem_norm[i]),
                                       xattn_w_q[i], xattn_w_kv[i], xattn_w_o[i])
        x = x + 0.5 * swiglu(rmsnorm(x, ffn2_norm[i]), ffn2_w_gate_up[i], ffn2_w_down[i])
    return rmsnorm(x, final_norm)
```

```cpp
#include <hip/hip_runtime.h>
#include <cstdio>
#include <cstdint>
#include <cmath>
#ifndef MK_F16
#define MK_F16 0
#endif
namespace st16 {
typedef short s16x8 __attribute__((ext_vector_type(8)));
typedef float v4f __attribute__((ext_vector_type(4)));
typedef float v16f __attribute__((ext_vector_type(16)));
#if MK_F16
typedef _Float16 h16x8 __attribute__((ext_vector_type(8)));
typedef _Float16 h16x2 __attribute__((ext_vector_type(2)));
typedef float v2f __attribute__((ext_vector_type(2)));
__device__ __forceinline__ unsigned pack(float lo, float hi) { unsigned r; asm volatile("v_cvt_pk_f16_f32 %0, %1, %2" : "=v"(r) : "v"(lo), "v"(hi)); return r; }
__device__ __forceinline__ float lo(unsigned w) { return (float)__builtin_bit_cast(h16x2, w)[0]; }
__device__ __forceinline__ float hi(unsigned w) { return (float)__builtin_bit_cast(h16x2, w)[1]; }
__device__ __forceinline__ v4f mfma16(s16x8 a, s16x8 b, v4f c) { return __builtin_amdgcn_mfma_f32_16x16x32_f16(__builtin_bit_cast(h16x8, a), __builtin_bit_cast(h16x8, b), c, 0, 0, 0); }
__device__ __forceinline__ v16f mfma32(s16x8 a, s16x8 b, v16f c) { return __builtin_amdgcn_mfma_f32_32x32x16_f16(__builtin_bit_cast(h16x8, a), __builtin_bit_cast(h16x8, b), c, 0, 0, 0); }
#else
__device__ __forceinline__ unsigned pack(float lo, float hi) { unsigned r; asm volatile("v_cvt_pk_bf16_f32 %0, %1, %2" : "=v"(r) : "v"(lo), "v"(hi)); return r; }
__device__ __forceinline__ float lo(unsigned w) { return __uint_as_float(w << 16); }
__device__ __forceinline__ float hi(unsigned w) { return __uint_as_float(w & 0xffff0000u); }
__device__ __forceinline__ v4f mfma16(s16x8 a, s16x8 b, v4f c) { return __builtin_amdgcn_mfma_f32_16x16x32_bf16(a, b, c, 0, 0, 0); }
__device__ __forceinline__ v16f mfma32(s16x8 a, s16x8 b, v16f c) { return __builtin_amdgcn_mfma_f32_32x32x16_bf16(a, b, c, 0, 0, 0); }
#endif
}

namespace pg8 {
#define PG8_LAS __attribute__((address_space(3)))
typedef unsigned short bf16_t;
typedef short bf16x8 __attribute__((ext_vector_type(8)));
typedef float f32x4 __attribute__((ext_vector_type(4)));
typedef unsigned u32x4 __attribute__((ext_vector_type(4)));
constexpr int BM = 256, BK = 64, HALF = 128, HTB = HALF * BK * 2  , STAGE_BYTES = 8 * HTB, NXCD = 8, WGM = 8;

__host__ __device__ __forceinline__ int lds_byte(int r, int c) { const int st = (r >> 4) * 2 + (c >> 5), rr = r & 15, cc = c & 31, ob = rr * 64 + cc * 2; return st * 1024 + (ob ^ (((ob >> 9) & 1) << 5)); }
__host__ __device__ __forceinline__ void stage_rc(int b, int& R, int& C) { const int st = b / 1024, sb = b % 1024, swz = sb ^ (((sb >> 9) & 1) << 5); R = (st >> 1) * 16 + swz / 64; C = (st & 1) * 32 + (swz % 64) / 2; }
__host__ __device__ __forceinline__ int perm32(int rho) { const int n = rho >> 4, i = rho & 15; return 8 * (i >> 2) + 4 * n + (i & 3); }

struct Unit { int pm, pn; };
struct Gemm { const bf16_t* A; const bf16_t* Bt; int M, N, K; };

struct StaticOrder {
    int nM, nN, nwg, G, c;
    __host__ __device__ void init(int M, int N, int G_, int c_) { nM = M / BM; nN = N / BM; nwg = nM * nN; G = G_; c = c_; }
    __host__ __device__ bool next(int i, Unit& u) const {
        const long L = (long)i * G + c; if (L >= nwg) return false;
        int wgid = (int)L; { const int q = nwg / NXCD, r = nwg % NXCD, xcd = wgid % NXCD, off = wgid / NXCD; wgid = (xcd < r ? xcd * (q + 1) : r * (q + 1) + (xcd - r) * q) + off; }
        const int nig = WGM * nN, gid = wgid / nig, fm = gid * WGM, gsz = (nM - fm) < WGM ? (nM - fm) : WGM;
        u.pm = fm + ((wgid % nig) % gsz); u.pn = (wgid % nig) / gsz; return true;
    }
    __device__ __forceinline__ void a_ready(const Unit&) const {}
    __device__ __forceinline__ void done(const Unit&) const {}
};
struct GroupOrder {
    int nM, nN, nwg, G, c, nx, wgm;
    __host__ __device__ void init(int M, int N, int G_, int c_, int nx_, int wgm_ = WGM) { nM = M / BM; nN = N / BM; nwg = nM * nN; G = G_; c = c_; nx = nx_; wgm = wgm_; }
    __host__ __device__ bool next(int i, Unit& u) const {
        const long L = (long)i * G + c; if (L >= nwg) return false;
        int wgid = (int)L; { const int q = nwg / nx, r = nwg % nx, xcd = wgid % nx, off = wgid / nx; wgid = (xcd < r ? xcd * (q + 1) : r * (q + 1) + (xcd - r) * q) + off; }
        const int nig = wgm * nN, gid = wgid / nig, fm = gid * wgm, gsz = (nM - fm) < wgm ? (nM - fm) : wgm;
        u.pm = fm + ((wgid % nig) % gsz); u.pn = (wgid % nig) / gsz; return true;
    }
    __device__ __forceinline__ void a_ready(const Unit&) const {}
    __device__ __forceinline__ void done(const Unit&) const {}
};

__device__ __forceinline__ unsigned cvt_pk_bf16(float lo, float hi) { return st16::pack(lo, hi); }
typedef float f32x2 __attribute__((ext_vector_type(2)));
constexpr float RMS_EPS = 1e-6f, INV_D = 1.0f / 2048.0f, LOG2E = 1.4426950408889634f;
typedef unsigned long long ssq_t;
constexpr float SSQ_SCALE = 16777216.0f;
__device__ __forceinline__ ssq_t ssq_fix(float s) { return (ssq_t)(s * SSQ_SCALE + 0.5f); }
__device__ __forceinline__ float rinv_of(const ssq_t* ss, int row) { const ssq_t s = ss[row]; const float sf = (float)(unsigned)(s >> 32) * 4294967296.0f + (float)(unsigned)s;
    return __builtin_amdgcn_rsqf(sf * (INV_D / SSQ_SCALE) + RMS_EPS); }

struct PreRinv { float ri[8]; };
struct PreNone {};
#ifndef EPI_REP
#define EPI_REP 1
#endif
struct EpiSwiGLU {
    static constexpr bool PERM = true, AFTER_DRAIN = false; static constexpr int REP = EPI_REP;
    bf16_t* O; int ldc; const ssq_t* ss; int roff;
    typedef PreNone Pre;
    __device__ __forceinline__ void prefetch(Pre&, const Unit&, int, int, int, int) const {}
    __device__ __forceinline__ void operator()(const f32x4 (&acc)[2][2][4][2], const Unit& u, int wr, int wc, int fr, int fq, const Pre&) const {
        const int row0 = roff + u.pm * BM + wr * 64 + fr, col0 = u.pn * HALF + wc * 32 + 8 * fq;
#pragma unroll
        for (int ai = 0; ai < 2; ++ai)
#pragma unroll
            for (int m = 0; m < 4; ++m) { const int r = row0 + ai * HALF + m * 16; const float ri = rinv_of(ss, r), rl = ri * (-LOG2E), rq = ri * ri;
                float h[8];
#pragma unroll
                for (int n = 0; n < 2; ++n)
#pragma unroll
                    for (int j = 0; j < 4; j += 2) {
                        const f32x2 g = (f32x2){acc[ai][0][m][n][j], acc[ai][0][m][n][j + 1]}, uu = (f32x2){acc[ai][1][m][n][j], acc[ai][1][m][n][j + 1]};
                        const f32x2 t = g * rl; f32x2 e; e.x = __builtin_amdgcn_exp2f(t.x); e.y = __builtin_amdgcn_exp2f(t.y);
                        const f32x2 d = e + 1.0f; f32x2 rc; rc.x = __builtin_amdgcn_rcpf(d.x); rc.y = __builtin_amdgcn_rcpf(d.y);
                        const f32x2 hv = (g * uu) * (rc * rq); h[4 * n + j] = hv.x; h[4 * n + j + 1] = hv.y; }
                u32x4 w; w.x = cvt_pk_bf16(h[0], h[1]); w.y = cvt_pk_bf16(h[2], h[3]); w.z = cvt_pk_bf16(h[4], h[5]); w.w = cvt_pk_bf16(h[6], h[7]);
                *(u32x4*)(O + (size_t)r * ldc + col0) = w; }
    }
};

struct EpiResid {
    static constexpr bool PERM = true, AFTER_DRAIN = false; static constexpr int REP = 1;
    bf16_t* xb; ssq_t* ssn; const float* bias; int roff;
    typedef PreNone Pre;
    __device__ __forceinline__ void prefetch(Pre&, const Unit&, int, int, int, int) const {}
    __device__ __forceinline__ void operator()(const f32x4 (&acc)[2][2][4][2], const Unit& u, int wr, int wc, int fr, int fq, const Pre&) const {
        const int row0 = roff + u.pm * BM + wr * 64 + fr, col0 = u.pn * BM + wc * 32 + 8 * fq;
        f32x4 bv[2][2];
#pragma unroll
        for (int bj = 0; bj < 2; ++bj)
#pragma unroll
            for (int n = 0; n < 2; ++n) bv[bj][n] = bias ? *(const f32x4*)(bias + col0 + bj * HALF + 4 * n) : (f32x4){0.f, 0.f, 0.f, 0.f};
#pragma unroll
        for (int ai = 0; ai < 2; ++ai)
#pragma unroll
            for (int m = 0; m < 4; ++m) { const int r = row0 + ai * HALF + m * 16; float sq = 0.f;
#pragma unroll
                for (int bj = 0; bj < 2; ++bj) { bf16_t* p = xb + (size_t)r * 2048 + col0 + bj * HALF;
                    const u32x4 xo = *(const u32x4*)p;
                    f32x4 v0, v1;
                    v0[0] = st16::lo(xo.x); v0[1] = st16::hi(xo.x); v0[2] = st16::lo(xo.y); v0[3] = st16::hi(xo.y);
                    v1[0] = st16::lo(xo.z); v1[1] = st16::hi(xo.z); v1[2] = st16::lo(xo.w); v1[3] = st16::hi(xo.w);
                    v0 = v0 + acc[ai][bj][m][0] + bv[bj][0]; v1 = v1 + acc[ai][bj][m][1] + bv[bj][1];
                    u32x4 w; w.x = cvt_pk_bf16(v0[0], v0[1]); w.y = cvt_pk_bf16(v0[2], v0[3]); w.z = cvt_pk_bf16(v1[0], v1[1]); w.w = cvt_pk_bf16(v1[2], v1[3]);
                    *(u32x4*)p = w;
                    sq += (v0[0] * v0[0] + v0[1] * v0[1]) + (v0[2] * v0[2] + v0[3] * v0[3]) + (v1[0] * v1[0] + v1[1] * v1[1]) + (v1[2] * v1[2] + v1[3] * v1[3]); }
                sq += __shfl_xor(sq, 16); sq += __shfl_xor(sq, 32);
                if (fq == 0) atomicAdd(ssn + r, ssq_fix(sq)); }
    }
};

struct EpiProj {
    static constexpr bool PERM = true, AFTER_DRAIN = false; static constexpr int REP = 1;
    bf16_t* d0; size_t tstride; int ld0, ld12, t1, t2; const ssq_t* ss; const float* bias; float qscale; int hd; const float* rtab; int roff; int tl;
    typedef PreNone Pre;
    __device__ __forceinline__ void prefetch(Pre&, const Unit&, int, int, int, int) const {}
    __device__ __forceinline__ void operator()(const f32x4 (&acc)[2][2][4][2], const Unit& u, int wr, int wc, int fr, int fq, const Pre&) const {
        const int pn = u.pn; const int tsel = pn >= t2 ? 2 : (pn >= t1 ? 1 : 0);
        bf16_t* base = d0 + (size_t)tsel * tstride; const int ld = tsel == 0 ? ld0 : ld12; const int tf = pn >= t2 ? t2 : (pn >= t1 ? t1 : 0);
        const float sc = tsel == 0 ? qscale : 1.0f;
        const int row0 = roff + u.pm * BM + wr * 64 + fr, col0 = (pn - tf) * BM + wc * 32 + 8 * fq, gcol0 = pn * BM + wc * 32 + 8 * fq;
        const bool rotw = (hd != 0) && (tsel < 2) && (hd == 128 ? (wc == 0) : ((wc & 1) == 0));
        const bool rotl = (hd == 128) ? true : (fq < 2);
        const int half = hd >> 3, xr = hd >> 2;
        const int ii0 = (hd == 128) ? 8 * (fq & 1) : 0;
        const float sgn = ((hd == 128) ? (fq < 2) : (fq == 0)) ? -1.0f : 1.0f;
#pragma unroll
        for (int ai = 0; ai < 2; ++ai)
#pragma unroll
            for (int m = 0; m < 4; ++m) { const int r = row0 + ai * HALF + m * 16; const float ri = rinv_of(ss, r);
                f32x4 cs[4];
                if (rotw) { const f32x4* tp = (const f32x4*)(rtab + ((size_t)r * half + ii0) * 2);
#pragma unroll
                    for (int q = 0; q < 4; ++q) cs[q] = tp[q]; }
#pragma unroll
                for (int bj = 0; bj < 2; ++bj) { float v[8];
                    f32x4 b0 = (f32x4){0.f, 0.f, 0.f, 0.f}, b1 = b0;
                    if (bias) { b0 = *(const f32x4*)(bias + gcol0 + bj * HALF); b1 = *(const f32x4*)(bias + gcol0 + bj * HALF + 4); }
#pragma unroll
                    for (int j = 0; j < 4; ++j) { v[j] = acc[ai][bj][m][0][j] * ri + b0[j]; v[4 + j] = acc[ai][bj][m][1][j] * ri + b1[j]; }
                    if (rotw) {
#pragma unroll
                        for (int i = 0; i < 8; ++i) { const float o = __shfl_xor(v[i], xr); const float c = cs[i >> 1][2 * (i & 1)], s = cs[i >> 1][2 * (i & 1) + 1];
                            const float nv = v[i] * c + sgn * o * s; v[i] = rotl ? nv : v[i]; } }
                    u32x4 w; w.x = cvt_pk_bf16(v[0] * sc, v[1] * sc); w.y = cvt_pk_bf16(v[2] * sc, v[3] * sc); w.z = cvt_pk_bf16(v[4] * sc, v[5] * sc); w.w = cvt_pk_bf16(v[6] * sc, v[7] * sc);
                    const int cq = col0 + bj * HALF;
                    unsigned off = (unsigned)r * (unsigned)ld + (unsigned)cq;
                    if ((tl >> tsel) & 1) {
                        const int hdl = (tl & 512) ? 6 : 7;
                        const int lsq = 8 + ((tl >> 4) & 15), H = ld >> hdl, head = __builtin_amdgcn_readfirstlane(cq >> hdl), cc = cq & ((1 << hdl) - 1);
                        const int l2d = (tl & 256) ? 2 * (head >> 2) : 0;
                        const unsigned b = (unsigned)r >> lsq, pos = (unsigned)r & ((1u << lsq) - 1u), a = pos >> l2d, p = pos & ((1u << l2d) - 1u), ft = (p << (lsq - l2d - 5)) + (a >> 5);
                        off = ((((b * (unsigned)H + (unsigned)head) << (lsq - 5)) + ft) * (unsigned)(1 << (hdl - 4)) + (unsigned)(cc >> 4)) * 512u + (unsigned)(((cc >> 3) & 1) * 32) * 8u + (a & 31u) * 8u; }
                    *(u32x4*)(base + off) = w; } }
    }
};

template <class Epi, class Sched, bool ALIGN_EPI = false, bool SP2 = false>
__device__ __forceinline__ void gemm_phase(PG8_LAS unsigned char* lds, const Gemm g, const Sched& S, const Epi& E, const int wave_in) {
    int tid0; asm volatile("v_mbcnt_lo_u32_b32 %0, -1, 0\n\tv_mbcnt_hi_u32_b32 %0, -1, %0" : "=v"(tid0)); tid0 += wave_in * 64;
    const int tid = tid0, wid = __builtin_amdgcn_readfirstlane(tid >> 6), lane = tid & 63, wr = wid >> 2, wc = wid & 3, fr = lane & 15, fq = lane >> 4;
    const int K = g.K, nt = K / BK;
    unsigned voffA[2], voffB[2];
#pragma unroll
    for (int i = 0; i < 2; ++i) { int R, C; stage_rc(tid * 16 + i * 8192, R, C); const int Rb = Epi::PERM ? ((R & ~31) + perm32(R & 31)) : R;
        voffA[i] = (unsigned)(R * K + C) * 2u; voffB[i] = (unsigned)(Rb * K + C) * 2u; }
    const size_t kstep = (size_t)(BK * 2);
    const size_t hstep = (size_t)HALF * K * 2;
    const size_t tstep = 2 * hstep;
    const unsigned ldsw = (unsigned)wid * 1024u;
    const int aoff = lds_byte(wr * 64 + fr, fq * 8), boff = lds_byte(wc * 32 + fr, fq * 8);
#define PG8_SA(b, h) (((b) * 2 + (h)) * HTB)
#define PG8_SB(b, h) ((4 + (b) * 2 + (h)) * HTB)
#define PG8_STAGE(bufoff, gbase, voff) do { _Pragma("unroll") for (int _i = 0; _i < 2; ++_i) \
        __builtin_amdgcn_global_load_lds((const unsigned*)((const char*)(gbase) + (voff)[_i]), (PG8_LAS unsigned*)(lds + (bufoff) + ldsw + _i * 8192), 16, 0, 0); } while (0)
#define PG8_LDA(dst, b, h) do { _Pragma("unroll") for (int m = 0; m < 4; ++m) _Pragma("unroll") for (int k = 0; k < 2; ++k) dst[m][k] = *(const PG8_LAS bf16x8*)(lds + PG8_SA(b, h) + aoff + m * 2048 + k * 1024); } while (0)
#define PG8_LDB(dst, b, h) do { _Pragma("unroll") for (int n = 0; n < 2; ++n) _Pragma("unroll") for (int k = 0; k < 2; ++k) dst[n][k] = *(const PG8_LAS bf16x8*)(lds + PG8_SB(b, h) + boff + n * 2048 + k * 1024); } while (0)
#define PG8_MMA(ai, bj, At, Bt) do { __builtin_amdgcn_s_setprio(1); _Pragma("unroll") for (int m = 0; m < 4; ++m) _Pragma("unroll") for (int n = 0; n < 2; ++n) _Pragma("unroll") for (int k = 0; k < 2; ++k) \
        acc[ai][bj][m][n] = st16::mfma16(Bt[n][k], At[m][k], acc[ai][bj][m][n]); __builtin_amdgcn_s_setprio(0); } while (0)
#define PG8_WAIT_V(n) asm volatile("s_waitcnt vmcnt(" #n ")" ::: "memory")
#define PG8_WAIT_L(n) asm volatile("s_waitcnt lgkmcnt(" #n ")" ::: "memory")
#define PG8_BAR __builtin_amdgcn_s_barrier()
#define PG8_SCHED __builtin_amdgcn_sched_barrier(0)
    Unit cur, nxt; int ui = 0;
    if (!S.next(0, cur)) return;
    f32x4 acc[2][2][4][2];
    typename Epi::Pre pre;
#pragma unroll
    for (int a = 0; a < 2; ++a)
#pragma unroll
        for (int b = 0; b < 2; ++b)
#pragma unroll
            for (int m = 0; m < 4; ++m)
#pragma unroll
                for (int n = 0; n < 2; ++n) acc[a][b][m][n] = (f32x4){0.f, 0.f, 0.f, 0.f};
    bf16x8 At[4][2], B0[2][2], B1[2][2];
    const char* cA = (const char*)g.A + (size_t)cur.pm * tstep; const char* cB = (const char*)g.Bt + (size_t)cur.pn * tstep;
    S.a_ready(cur);
    if constexpr (SP2) {
        PG8_STAGE(PG8_SB(0, 0), cB, voffB); PG8_STAGE(PG8_SB(0, 1), cB + hstep, voffB); PG8_STAGE(PG8_SA(0, 0), cA, voffA); PG8_STAGE(PG8_SA(0, 1), cA + hstep, voffA);
        if (wr == 1) PG8_BAR;
        PG8_WAIT_V(2); PG8_BAR;
        PG8_STAGE(PG8_SB(1, 0), cB + kstep, voffB); PG8_STAGE(PG8_SA(1, 0), cA + kstep, voffA); PG8_STAGE(PG8_SB(1, 1), cB + hstep + kstep, voffB);
        PG8_WAIT_V(6); PG8_BAR;
    } else {
        PG8_STAGE(PG8_SB(0, 0), cB, voffB); PG8_STAGE(PG8_SA(0, 0), cA, voffA); PG8_STAGE(PG8_SB(0, 1), cB + hstep, voffB); PG8_STAGE(PG8_SA(0, 1), cA + hstep, voffA);
        if (wr == 1) PG8_BAR;
        PG8_WAIT_V(4); PG8_BAR;
        PG8_STAGE(PG8_SB(1, 0), cB + kstep, voffB); PG8_STAGE(PG8_SA(1, 0), cA + kstep, voffA); PG8_STAGE(PG8_SB(1, 1), cB + hstep + kstep, voffB);
        PG8_WAIT_V(6); PG8_BAR;
    }
    for (;;) {
        const bool has_next = S.next(ui + 1, nxt);
        const char* nA = has_next ? (const char*)g.A + (size_t)nxt.pm * tstep : cA; const char* nB = has_next ? (const char*)g.Bt + (size_t)nxt.pn * tstep : cB;
        for (int t = 0; t < nt; t += 2) {
            const bool last = (t == nt - 2);
            const char* a1 = cA + (size_t)(t + 1) * kstep;
            const char* a2 = last ? nA : cA + (size_t)(t + 2) * kstep; const char* b2 = last ? nB : cB + (size_t)(t + 2) * kstep;
            const char* a3 = a2 + kstep; const char* b3 = b2 + kstep;
            if (last && has_next) S.a_ready(nxt);
            if (last) E.prefetch(pre, cur, wr, wc, fr, fq);
            if constexpr (SP2) {
            PG8_LDB(B0, 0, 0); PG8_LDB(B1, 0, 1); PG8_SCHED; PG8_LDA(At, 0, 0); PG8_STAGE(PG8_SA(1, 1), a1 + hstep, voffA);
            PG8_WAIT_V(8); PG8_WAIT_L(0); PG8_BAR; PG8_MMA(0, 0, At, B0); PG8_MMA(0, 1, At, B1); PG8_BAR; PG8_SCHED;
            PG8_LDA(At, 0, 1); PG8_STAGE(PG8_SB(0, 0), b2, voffB); PG8_STAGE(PG8_SB(0, 1), b2 + hstep, voffB); PG8_STAGE(PG8_SA(0, 0), a2, voffA);
            PG8_WAIT_V(8); PG8_WAIT_L(0); PG8_BAR; PG8_MMA(1, 0, At, B0); PG8_MMA(1, 1, At, B1); PG8_BAR; PG8_SCHED;
            PG8_LDB(B0, 1, 0); PG8_LDB(B1, 1, 1); PG8_SCHED; PG8_LDA(At, 1, 0); PG8_STAGE(PG8_SA(0, 1), a2 + hstep, voffA);
            PG8_WAIT_V(8); PG8_WAIT_L(0); PG8_BAR; PG8_MMA(0, 0, At, B0); PG8_MMA(0, 1, At, B1); PG8_BAR; PG8_SCHED;
            PG8_LDA(At, 1, 1); PG8_STAGE(PG8_SB(1, 0), b3, voffB); PG8_STAGE(PG8_SB(1, 1), b3 + hstep, voffB); PG8_STAGE(PG8_SA(1, 0), a3, voffA);
            PG8_WAIT_V(8); PG8_WAIT_L(0); PG8_BAR; PG8_MMA(1, 0, At, B0); PG8_MMA(1, 1, At, B1); PG8_BAR; PG8_SCHED;
            } else {
            PG8_LDB(B0, 0, 0); PG8_SCHED; PG8_LDA(At, 0, 0); PG8_STAGE(PG8_SA(1, 1), a1 + hstep, voffA);
            PG8_WAIT_L(8); PG8_BAR; PG8_WAIT_L(0); PG8_MMA(0, 0, At, B0); PG8_BAR; PG8_SCHED;
            PG8_LDB(B1, 0, 1); PG8_STAGE(PG8_SB(0, 0), b2, voffB);
            PG8_BAR; PG8_WAIT_L(0); PG8_MMA(0, 1, At, B1); PG8_BAR;
            PG8_LDA(At, 0, 1); PG8_STAGE(PG8_SA(0, 0), a2, voffA);
            PG8_BAR; PG8_WAIT_L(0); PG8_MMA(1, 0, At, B0); PG8_BAR; PG8_SCHED;
            PG8_STAGE(PG8_SB(0, 1), b2 + hstep, voffB);
            PG8_WAIT_V(6); PG8_BAR; PG8_MMA(1, 1, At, B1); PG8_BAR;
            PG8_LDB(B0, 1, 0); PG8_SCHED; PG8_LDA(At, 1, 0); PG8_STAGE(PG8_SA(0, 1), a2 + hstep, voffA);
            PG8_WAIT_L(8); PG8_BAR; PG8_WAIT_L(0); PG8_MMA(0, 0, At, B0); PG8_BAR; PG8_SCHED;
            PG8_LDB(B1, 1, 1); PG8_STAGE(PG8_SB(1, 0), b3, voffB);
            PG8_BAR; PG8_WAIT_L(0); PG8_MMA(0, 1, At, B1); PG8_BAR;
            PG8_LDA(At, 1, 1); PG8_STAGE(PG8_SA(1, 0), a3, voffA);
            PG8_BAR; PG8_WAIT_L(0); PG8_MMA(1, 0, At, B0); PG8_BAR; PG8_SCHED;
            PG8_STAGE(PG8_SB(1, 1), b3 + hstep, voffB);
            PG8_WAIT_V(6); PG8_BAR; PG8_MMA(1, 1, At, B1); PG8_BAR;
            }
        }
        if constexpr (ALIGN_EPI) { if (wr == 0) PG8_BAR; }
        if constexpr (!Epi::AFTER_DRAIN) { for (int er_ = 0; er_ < Epi::REP; ++er_) E(acc, cur, wr, wc, fr, fq, pre); S.done(cur); }
        if (!has_next) break;
#pragma unroll
        for (int a = 0; a < 2; ++a)
#pragma unroll
            for (int b = 0; b < 2; ++b)
#pragma unroll
                for (int m = 0; m < 4; ++m)
#pragma unroll
                    for (int n = 0; n < 2; ++n) acc[a][b][m][n] = (f32x4){0.f, 0.f, 0.f, 0.f};
        cur = nxt; cA = nA; cB = nB; ++ui;
        if constexpr (ALIGN_EPI) { if (wr == 1) PG8_BAR; }
    }
    PG8_WAIT_V(0);
    if constexpr (!ALIGN_EPI) { if (wr == 0) PG8_BAR; }
    PG8_BAR;
    if constexpr (Epi::AFTER_DRAIN) { E.fused(acc, cur, wr, wc, fr, fq, lds, wid, lane); S.done(cur); }
#undef PG8_SA
#undef PG8_SB
#undef PG8_STAGE
#undef PG8_LDA
#undef PG8_LDB
#undef PG8_MMA
#undef PG8_WAIT_V
#undef PG8_WAIT_L
#undef PG8_BAR
#undef PG8_SCHED
}
}

namespace wa {
#ifndef WA_MASK_SKIP
#define WA_MASK_SKIP 1
#endif
#define WA_LAS __attribute__((address_space(3)))
typedef unsigned short bf16_t;
typedef short bf16x8 __attribute__((ext_vector_type(8)));
typedef short s16x4 __attribute__((ext_vector_type(4)));
typedef float f32x16 __attribute__((ext_vector_type(16)));
typedef float f32x4 __attribute__((ext_vector_type(4)));
typedef unsigned u32x4 __attribute__((ext_vector_type(4)));
typedef unsigned u32x2 __attribute__((ext_vector_type(2)));
constexpr float LOG2E = 1.4426950408889634f, LN2 = 0.6931471805599453f;
__device__ __forceinline__ unsigned cvtpk(float lo, float hi) { return st16::pack(lo, hi); }
__device__ __forceinline__ s16x4 vtr(const WA_LAS unsigned char* p) { return __builtin_bit_cast(s16x4, __builtin_amdgcn_ds_read_tr16_b64_v4i16((WA_LAS s16x4*)p)); }
__device__ __forceinline__ int kofs(int reg, int hh) { return (reg & 3) + 8 * (reg >> 2) + 4 * hh; }

template <int HD> struct VRegs { u32x4 t[32 / (64 / (HD / 8))]; };
template <int HD> __device__ __forceinline__ void load_v(VRegs<HD>& R, const bf16_t* v, long vstride, int kp0, int nkeys, int lane) {
    constexpr int LPR = HD / 8  , RPI = 64 / LPR  ;
#pragma unroll
    for (int i = 0; i < 32 / RPI; ++i) { const int row = i * RPI + lane / LPR; int kp = kp0 + row; kp = kp < 0 ? 0 : (kp >= nkeys ? nkeys - 1 : kp);
        R.t[i] = *(const u32x4*)(v + (long)kp * vstride + (lane % LPR) * 8); }
}
template <int HD> __device__ __forceinline__ void write_v(const VRegs<HD>& R, WA_LAS unsigned char* vl, int lane) {
    constexpr int VP = HD * 2 + 64, LPR = HD / 8, RPI = 64 / LPR;
#pragma unroll
    for (int i = 0; i < 32 / RPI; ++i) { const int row = i * RPI + lane / LPR; *(WA_LAS u32x4*)(vl + row * VP + (lane % LPR) * 16) = R.t[i]; }
}
template <int HD> __device__ __forceinline__ void stage_v(WA_LAS unsigned char* vl, const bf16_t* v, long vstride, int kp0, int nkeys, int lane) {
    VRegs<HD> R; load_v<HD>(R, v, vstride, kp0, nkeys, lane); write_v<HD>(R, vl, lane);
}
template <int HD> __device__ __forceinline__ void pv_tile(f32x16 (&o)[HD / 32], const f32x16& p, const WA_LAS unsigned char* vl, int lane) {
    constexpr int VP = HD * 2 + 64;
    const int hh = lane >> 5, i16 = lane & 15, q4 = i16 >> 2, p4 = i16 & 3, dsel = (lane >> 4) & 1;
    bf16x8 pb[2];
#pragma unroll
    for (int s2 = 0; s2 < 2; ++s2) { u32x4 w; w.x = cvtpk(p[8 * s2 + 0], p[8 * s2 + 1]); w.y = cvtpk(p[8 * s2 + 2], p[8 * s2 + 3]); w.z = cvtpk(p[8 * s2 + 4], p[8 * s2 + 5]); w.w = cvtpk(p[8 * s2 + 6], p[8 * s2 + 7]);
        pb[s2] = __builtin_bit_cast(bf16x8, w); }
    const WA_LAS unsigned char* base = vl + (4 * hh + q4) * VP + (16 * dsel + 4 * p4) * 2;
#pragma unroll
    for (int dc = 0; dc < HD / 32; ++dc)
#pragma unroll
        for (int s2 = 0; s2 < 2; ++s2) {
            const s16x4 lo = vtr(base + (16 * s2) * VP + dc * 64), hi = vtr(base + (16 * s2 + 8) * VP + dc * 64);
            const bf16x8 a = (bf16x8){lo[0], lo[1], lo[2], lo[3], hi[0], hi[1], hi[2], hi[3]};
            o[dc] = st16::mfma32(a, pb[s2], o[dc]);
        }
}
template <int HD> __device__ __forceinline__ void store_o(const f32x16 (&o)[HD / 32], float scale, bf16_t* orow, int hh) {
#pragma unroll
    for (int dc = 0; dc < HD / 32; ++dc)
#pragma unroll
        for (int g = 0; g < 4; ++g) { u32x2 w; w.x = cvtpk(o[dc][4 * g] * scale, o[dc][4 * g + 1] * scale); w.y = cvtpk(o[dc][4 * g + 2] * scale, o[dc][4 * g + 3] * scale);
            *(u32x2*)(orow + 32 * dc + 8 * g + 4 * hh) = w; }
}

#ifndef WA_OLDS_SM
#define WA_OLDS_SM 1
#endif
#ifndef WA_OLDS_SB
#define WA_OLDS_SB 1
#endif
template <int HD> __device__ __forceinline__ void store_o_lds(const f32x16 (&o)[HD / 32], float scale, bf16_t* obase, long ostride, WA_LAS unsigned char* vl, int lane) {
    constexpr int P = HD * 2 + 16, LPR = HD / 8, RPI = 64 / LPR;
    asm volatile("v_mbcnt_lo_u32_b32 %0, -1, 0\n\tv_mbcnt_hi_u32_b32 %0, -1, %0" : "=v"(lane));
    const int q = lane & 31, hh = lane >> 5;
#pragma unroll
    for (int dc = 0; dc < HD / 32; ++dc)
#pragma unroll
        for (int g = 0; g < 4; ++g) { u32x2 w; w.x = cvtpk(o[dc][4 * g] * scale, o[dc][4 * g + 1] * scale); w.y = cvtpk(o[dc][4 * g + 2] * scale, o[dc][4 * g + 3] * scale);
            *(WA_LAS u32x2*)(vl + q * P + (32 * dc + 8 * g + 4 * hh) * 2) = w; }
#pragma unroll
    for (int j = 0; j < 32 / RPI; ++j) { const int row = j * RPI + lane / LPR;
        const u32x4 w = *(const WA_LAS u32x4*)(vl + row * P + (lane % LPR) * 16);
        *(u32x4*)(obase + (long)row * ostride + (lane % LPR) * 8) = w; }
}

struct SmUnit {
    const bf16_t* q;
    const bf16_t* k;
    const bf16_t* v;
    bf16_t* o;
    long qstride, kstride, vstride, ostride;
    int qpos0, kpos0, nkeys, maxdist, causal;
    float sink;
    float* lse; long lsestride;
    const bf16_t* qt; const bf16_t* kt; int ntiles;
};
template <int HD, int TPC, int NCH, bool SINK, bool LSE, bool TIL, bool ROT = false>
__device__ __forceinline__ void sm_unit(const SmUnit& U, WA_LAS unsigned char* vl, int lane) {
    const int r = lane & 31, hh = lane >> 5;
    bf16x8 qf[HD / 16];
    { const bf16_t* qp = TIL ? U.qt + lane * 8 : U.q + (long)r * U.qstride + 8 * hh;
#pragma unroll
      for (int s = 0; s < HD / 16; ++s) qf[s] = *(const bf16x8*)(qp + (TIL ? 512 : 16) * s); }
    f32x16 o[HD / 32];
#pragma unroll
    for (int dc = 0; dc < HD / 32; ++dc)
#pragma unroll
        for (int i = 0; i < 16; ++i) o[dc][i] = 0.f;
    float m = -1e30f, l = 0.f;
    const int qpos = U.qpos0 + r;
    const int rot = ROT ? (((U.kpos0 >> 5) % TPC) + TPC) % TPC : 0;
#define WA_TT(tau_) ((tau_) - rot < 0 ? (tau_) - rot + TPC : (tau_) - rot)
#pragma unroll 1
    for (int ch = 0; ch < NCH; ++ch) {
        const int kb = U.kpos0 + ch * TPC * 32;
        f32x16 S[TPC];
        constexpr bool VPF = (NCH == 1);
        VRegs<HD> vr; if (VPF) load_v<HD>(vr, U.v, U.vstride, kb + 32 * WA_TT(0), U.nkeys, lane);
        bf16x8 kf[HD / 16];
#define WA_KLOAD(dst, t_) do { int kp_ = kb + 32 * WA_TT(t_) + r; kp_ = kp_ < 0 ? 0 : (kp_ >= U.nkeys ? U.nkeys - 1 : kp_); int ti_ = (kb >> 5) + WA_TT(t_); ti_ = ti_ < 0 ? 0 : (ti_ >= U.ntiles ? U.ntiles - 1 : ti_); \
            const bf16_t* kptr_ = TIL ? U.kt + (long)ti_ * (HD / 16) * 512 + lane * 8 : U.k + (long)kp_ * U.kstride + 8 * hh; \
            _Pragma("unroll") for (int s = 0; s < HD / 16; ++s) dst[s] = *(const bf16x8*)(kptr_ + (TIL ? 512 : 16) * s); } while (0)
        WA_KLOAD(kf, 0);
#pragma unroll
        for (int t = 0; t < TPC; ++t) {
            bf16x8 kn[HD / 16];
            if (t + 1 < TPC) WA_KLOAD(kn, t + 1);
            asm volatile("" ::: "memory");
#pragma unroll
            for (int i = 0; i < 16; ++i) S[t][i] = 0.f;
#pragma unroll
            for (int s = 0; s < HD / 16; ++s) S[t] = st16::mfma32(kf[s], qf[s], S[t]);
            if (t + 1 < TPC) {
#pragma unroll
                for (int s = 0; s < HD / 16; ++s) kf[s] = kn[s]; }
        }
#undef WA_KLOAD
        float cm = -1e30f;
#pragma unroll
        for (int t = 0; t < TPC; ++t) {
            const int p0 = kb + 32 * WA_TT(t), p1 = p0 + 31;
            const bool allv = WA_MASK_SKIP && (p0 >= 0) && (p1 < U.nkeys) && (!U.causal || p1 <= U.qpos0) && (U.qpos0 + 31 - p0 <= U.maxdist);
            if (allv) {
#pragma unroll
                for (int i = 0; i < 16; ++i) cm = fmaxf(cm, S[t][i]);
            } else {
#pragma unroll
                for (int i = 0; i < 16; ++i) { const int kp = p0 + kofs(i, hh);
                    const bool ok = (kp >= 0) && (kp < U.nkeys) && (!U.causal || kp <= qpos) && (qpos - kp <= U.maxdist);
                    const float sv = ok ? S[t][i] : -INFINITY; S[t][i] = sv; cm = fmaxf(cm, sv); }
            }
        }
        cm = fmaxf(cm, __shfl_xor(cm, 32));
        if (SINK && ch == 0) cm = fmaxf(cm, U.sink);
        const float mn = fmaxf(m, cm), alpha = __builtin_amdgcn_exp2f(m - mn);
        float ps = 0.f;
#pragma unroll
        for (int t = 0; t < TPC; ++t)
#pragma unroll
            for (int i = 0; i < 16; ++i) { const float p = __builtin_amdgcn_exp2f(S[t][i] - mn); S[t][i] = p; ps += p; }
        ps += __shfl_xor(ps, 32);
        if (SINK && ch == 0) ps += __builtin_amdgcn_exp2f(U.sink - mn);
        l = l * alpha + ps; m = mn;
        if (NCH > 1) {
#pragma unroll
            for (int dc = 0; dc < HD / 32; ++dc)
#pragma unroll
                for (int i = 0; i < 16; ++i) o[dc][i] *= alpha; }
        { if (!VPF) load_v<HD>(vr, U.v, U.vstride, kb + 32 * WA_TT(0), U.nkeys, lane);
          asm volatile("" : "+v"(S[0][0]) :: "memory");
#pragma unroll
          for (int t = 0; t < TPC; ++t) {
              VRegs<HD> vn; if (VPF && t + 1 < TPC) load_v<HD>(vn, U.v, U.vstride, kb + 32 * WA_TT(t + 1), U.nkeys, lane);
              write_v<HD>(vr, vl, lane); pv_tile<HD>(o, S[t], vl, lane);
              if (t + 1 < TPC) { if (VPF) vr = vn; else load_v<HD>(vr, U.v, U.vstride, kb + 32 * WA_TT(t + 1), U.nkeys, lane); } } }
    }
#undef WA_TT
    const float inv = 1.0f / l;
    if (WA_OLDS_SM) store_o_lds<HD>(o, inv, U.o, U.ostride, vl, lane); else store_o<HD>(o, inv, U.o + (long)r * U.ostride, hh);
    if (LSE) { if (hh == 0) U.lse[(long)r * U.lsestride] = (m + __builtin_amdgcn_logf(l)) * LN2; }
}

#ifndef SB_EARLY_EXIT
#define SB_EARLY_EXIT 1
#endif
constexpr float SB_EXIT_T = 110.0f;
template <int HD>
__device__ __forceinline__ void sb_unit(const bf16_t* qT, const bf16_t* kT, const bf16_t* v, bf16_t* o, long stride, int qpos0, WA_LAS unsigned char* vl, int lane) {
    const int r = lane & 31, hh = lane >> 5;
    bf16x8 qf[HD / 16];
    { const bf16_t* qp = qT + (long)(qpos0 >> 5) * (HD / 16) * 512 + lane * 8;
#pragma unroll
      for (int s = 0; s < HD / 16; ++s) qf[s] = *(const bf16x8*)(qp + 512 * s); }
    f32x16 oacc[HD / 32];
#pragma unroll
    for (int dc = 0; dc < HD / 32; ++dc)
#pragma unroll
        for (int i = 0; i < 16; ++i) oacc[dc][i] = 0.f;
    float carry = 1.f;
    const int qpos = qpos0 + r, ktd = qpos0 >> 5;
    bf16x8 kf[HD / 16];
    { const bf16_t* kptr = kT + (long)ktd * (HD / 16) * 512 + lane * 8;
#pragma unroll
      for (int s = 0; s < HD / 16; ++s) kf[s] = *(const bf16x8*)(kptr + 512 * s); }
    for (int kt = ktd; kt >= 0; --kt) {
        const int kn = kt > 0 ? kt - 1 : 0;
        VRegs<HD> vr; load_v<HD>(vr, v, stride, 32 * kt, 1 << 30, lane);
        bf16x8 kfn[HD / 16];
        { const bf16_t* kptr = kT + (long)kn * (HD / 16) * 512 + lane * 8;
#pragma unroll
          for (int s = 0; s < HD / 16; ++s) kfn[s] = *(const bf16x8*)(kptr + 512 * s); }
        asm volatile("" ::: "memory");
        f32x16 S;
#pragma unroll
        for (int i = 0; i < 16; ++i) S[i] = 0.f;
#pragma unroll
        for (int s = 0; s < HD / 16; ++s) S = st16::mfma32(kf[s], qf[s], S);
        const bool diag = (kt == ktd);
        float kp[16];
        f32x16 A;
#pragma unroll
        for (int i = 0; i < 16; ++i) { const float z = S[i]; const bool ok = !diag || (32 * kt + kofs(i, hh) < qpos);
            const float ez = __builtin_amdgcn_exp2f(-fabsf(z) * LOG2E), rc = __builtin_amdgcn_rcpf(1.0f + ez), er = ez * rc;
            const float sg = z >= 0.f ? rc : er, kk = z >= 0.f ? er : rc;
            A[i] = ok ? sg : 0.f; kp[i] = ok ? kk : 1.f; }
        float gs[4], pg[4];
#pragma unroll
        for (int g = 0; g < 4; ++g) { gs[g] = (kp[4 * g] * kp[4 * g + 1]) * (kp[4 * g + 2] * kp[4 * g + 3]); pg[g] = __shfl_xor(gs[g], 32); }
        float run = carry;
#pragma unroll
        for (int g = 3; g >= 0; --g) { const float T = run * (hh == 0 ? pg[g] : 1.f);
            const float t3 = T, t2 = t3 * kp[4 * g + 3], t1 = t2 * kp[4 * g + 2], t0 = t1 * kp[4 * g + 1];
            A[4 * g + 3] *= t3; A[4 * g + 2] *= t2; A[4 * g + 1] *= t1; A[4 * g] *= t0;
            run *= gs[g] * pg[g]; }
        carry = run;
        asm volatile("" : "+v"(A[0]), "+v"(A[15]) :: "memory");
        write_v<HD>(vr, vl, lane);
        pv_tile<HD>(oacc, A, vl, lane);
#if SB_EARLY_EXIT
        if (__all(carry == 0.f)) break;
#endif
#pragma unroll
        for (int s = 0; s < HD / 16; ++s) kf[s] = kfn[s];
    }
    if (WA_OLDS_SB) store_o_lds<HD>(oacc, 1.0f, o, stride, vl, lane); else store_o<HD>(oacc, 1.0f, o + (long)r * stride, hh);
}
}

constexpr int NWAVES = 8;
constexpr int BATCH = 4, SEQ = 4096, DM = 2048, DEPTH = 4, NMEM = 256, FF = 5632;
constexpr int MT = BATCH * SEQ;
constexpr int MMEM = BATCH * NMEM;
constexpr size_t MiB = 1u << 20;
constexpr size_t WS_CTL = 0;
constexpr size_t WS_SS = 1 * MiB;
constexpr size_t SS_BYTES = (size_t)MT * 8;
constexpr size_t ZERO_BYTES = 3328 * 1024;
constexpr size_t WS_W = 4 * MiB;
constexpr size_t WL_STRIDE = 168 * MiB, WL_GU1 = 0, WL_DN1 = 44 * MiB, WL_GU2 = 66 * MiB, WL_DN2 = 110 * MiB, WL_MQKV = 132 * MiB, WL_MO = 156 * MiB, WL_XQ = 164 * MiB, WL_XO = 166 * MiB;
constexpr size_t WS_WKV = WS_W + 4 * WL_STRIDE;
constexpr size_t WS_XB = WS_WKV + 16 * MiB;
constexpr size_t WS_MEMB = WS_XB + 64 * MiB;
constexpr size_t WS_ACT = WS_MEMB + 4 * MiB;
constexpr size_t WS_QKV = WS_ACT + 176 * MiB;
constexpr size_t WS_O = WS_QKV + 192 * MiB;
constexpr size_t WS_XQ = WS_O + 64 * MiB;
constexpr size_t WS_XO = WS_XQ + 16 * MiB;
constexpr size_t WS_KVM = WS_XO + 16 * MiB;
constexpr size_t WS_LSE = WS_KVM + 8 * MiB;
constexpr size_t WS_TABD = WS_LSE + 1 * MiB;
constexpr size_t WS_TABS = WS_TABD + 2 * MiB;
constexpr size_t WS_SSMEM = WS_TABS + 1 * MiB;
constexpr size_t WS_END = WS_SSMEM + 1 * MiB;
static_assert(WS_SS + 17 * SS_BYTES <= ZERO_BYTES && ZERO_BYTES <= WS_W, "zeroed region");
static_assert(WS_END < 1400ull * MiB, "workspace map must fit 4x the largest input tensor");
constexpr int CW_BAR = 4096;
constexpr int RING_OFF = 0, RING_BYTES = 131072;
constexpr int LDSCTL_OFF = 135168, MISC_OFF = LDSCTL_OFF + 320;
constexpr int LDS_BYTES = 147456;

#define GAS __attribute__((address_space(1)))
#define LAS __attribute__((address_space(3)))
typedef unsigned short bf16;
typedef unsigned v4u __attribute__((ext_vector_type(4)));
typedef unsigned v2u __attribute__((ext_vector_type(2)));
typedef float f32x4 __attribute__((ext_vector_type(4)));
#define LDS_WAIT() asm volatile("s_waitcnt lgkmcnt(0)" ::: "memory")
#define VM_WAIT() asm volatile("s_waitcnt vmcnt(0)" ::: "memory")
__device__ __forceinline__ unsigned pk2(float lo, float hi) { return pg8::cvt_pk_bf16(lo, hi); }
__device__ __forceinline__ float wave_sum(float v) {
#pragma unroll
    for (int o = 1; o < 64; o <<= 1) v += __shfl_xor(v, o);
    return v;
}
__device__ const float INVF_D[16] = {1.000000000e+00f, 4.403665960e-01f, 1.939227432e-01f, 8.539710194e-02f, 3.760603070e-02f, 1.656043902e-02f, 7.292664610e-03f, 3.211445874e-03f,
                                     1.414213562e-03f, 6.227723788e-04f, 2.742481884e-04f, 1.207697351e-04f, 5.318296098e-05f, 2.341999971e-05f, 1.031338616e-05f, 4.541670478e-06f};
__device__ const float INVF_S[8] = {1.000000000e+00f, 1.939227432e-01f, 3.760603070e-02f, 7.292664610e-03f, 1.414213562e-03f, 2.742481884e-04f, 5.318296098e-05f, 1.031338616e-05f};

#define XB_TMO      128
#define XB_XCNT(j)  (256  + 64 * (j))
#define XB_XSUB(j)  (1280 + 64 * (j))
#define XB_XGEN(j)  (2304 + 64 * (j))
#define XB_TOP      3328
#define XB_TOPGEN   3392
#define XCD_BAR_WORDS 3456
#define XB_SPIN_CAP (1u << 18)
#ifndef XB_FLAT_RELEASE
#define XB_FLAT_RELEASE 1
#endif

__device__ __forceinline__ unsigned xb_ld(unsigned* p)              { return __hip_atomic_load(p, __ATOMIC_RELAXED, __HIP_MEMORY_SCOPE_AGENT); }
__device__ __forceinline__ unsigned xb_add(unsigned* p, unsigned v) { return __hip_atomic_fetch_add(p, v, __ATOMIC_RELAXED, __HIP_MEMORY_SCOPE_AGENT); }
__device__ __forceinline__ unsigned xb_xcc_id() { return (unsigned)__builtin_amdgcn_s_getreg((3 << 11) | 20) & 0xFu; }
#define XB_SPIN(cond, bar) do { unsigned _sp = 0; while (cond) { __builtin_amdgcn_s_sleep(1); \
    if ((++_sp & 255u) == 0u) { if (xb_ld(&(bar)[XB_TMO])) break; if (_sp > XB_SPIN_CAP) { atomicAdd(&(bar)[XB_TMO], 1u); break; } } } } while (0)

struct XcdBarrier {
    unsigned* bar; unsigned x; unsigned ng;
    volatile LAS unsigned* st;
};

__device__ __forceinline__ XcdBarrier xcd_barrier_post(unsigned* bar, volatile LAS unsigned* st, const bool t0  ) {
    XcdBarrier b; b.bar = bar; b.x = xb_xcc_id(); b.st = st; b.ng = 0u;
    if (t0) (void)xb_add(&bar[XB_XCNT(b.x)], 1u);
    return b;
}
__device__ __forceinline__ void xcd_barrier_complete(unsigned* bar, unsigned x, unsigned& nloc, unsigned& nx, const unsigned G) {
    unsigned sum, cnt, mine, sp = 0u;
    for (;;) {
        sum = 0u; cnt = 0u; mine = 0u;
#pragma unroll
        for (unsigned j = 0; j < 16; ++j) { const unsigned c = xb_ld(&bar[XB_XCNT(j)]); sum += c; cnt += (c > 0u) ? 1u : 0u; mine = (j == x) ? c : mine; }
        if (sum == G) break;
        __builtin_amdgcn_s_sleep(1);
        if ((++sp & 255u) == 0u) { if (xb_ld(&bar[XB_TMO])) break; if (sp > XB_SPIN_CAP) { atomicAdd(&bar[XB_TMO], 1u); break; } }
    }
    nloc = mine > 0u ? mine : 1u; nx = cnt > 0u ? cnt : 1u;
}

__device__ __forceinline__ void xcd_barrier(const XcdBarrier& b, const bool t0) {
    asm volatile("s_waitcnt vmcnt(0)" ::: "memory");
    __syncthreads();
    if (t0) {
        unsigned* bar = b.bar;
        __builtin_amdgcn_s_waitcnt(0);
        unsigned nloc = b.st[0], nx = b.st[1];
        if (nloc == 0u) { xcd_barrier_complete(bar, b.x, nloc, nx, b.ng); b.st[0] = nloc; b.st[1] = nx; }
        const unsigned old = xb_add(&bar[XB_XSUB(b.x)], 1u);
        const unsigned gen = old / nloc;
        if (old + 1u == (gen + 1u) * nloc) {
            __builtin_amdgcn_fence(__ATOMIC_RELEASE, "agent");
            asm volatile("s_waitcnt vmcnt(0)" ::: "memory");
            const unsigned og = xb_add(&bar[XB_TOP], 1u);
            const unsigned tg = og / nx;
            if (og + 1u == (tg + 1u) * nx) xb_add(&bar[XB_TOPGEN], 1u);
            else XB_SPIN(xb_ld(&bar[XB_TOPGEN]) == tg, bar);
            __builtin_amdgcn_fence(__ATOMIC_ACQUIRE, "agent");
            if (!XB_FLAT_RELEASE) xb_add(&bar[XB_XGEN(b.x)], 1u);
            asm volatile("s_waitcnt vmcnt(0)" ::: "memory");
        } else {
            if (XB_FLAT_RELEASE) XB_SPIN(xb_ld(&bar[XB_TOPGEN]) == gen, bar);
            else XB_SPIN(xb_ld(&bar[XB_XGEN(b.x)]) == gen, bar);
            __builtin_amdgcn_fence(__ATOMIC_ACQUIRE, "agent");
            asm volatile("s_waitcnt vmcnt(0)" ::: "memory");
        }
    }
    __syncthreads();
}

__device__ __forceinline__ void conv_items(int& it, const int NGW, const float* W, const int K, const int N, const float* gain, const float scale, bf16* WT, const int mode, const int lane) {
    const int nblk = N >> 6, nitems = (K >> 6) * nblk, g = lane >> 4, j = lane & 15;
    while (it < nitems) {
        const int kb = it / nblk, nb = it - kb * nblk, k0 = kb << 6, n0 = nb << 6;
        const float* src = W + (size_t)(k0 + 16 * g) * N + n0 + 4 * j;
        f32x4 t[16];
#pragma unroll
        for (int i = 0; i < 16; ++i) t[i] = *(const f32x4*)(src + (size_t)i * N);
        f32x4 gv[4];
#pragma unroll
        for (int q = 0; q < 4; ++q) gv[q] = gain ? *(const f32x4*)(gain + k0 + 16 * g + 4 * q) * scale : (f32x4){scale, scale, scale, scale};
        int drow0 = n0; if (mode == 1) { const int hf = n0 >= FF ? 1 : 0; const int j0 = n0 - hf * FF; drow0 = (j0 >> 7) * 256 + hf * 128 + (j0 & 127); }
        if (mode >= 16) drow0 = (n0 < 512 ? 0 : 2048 - 512) + (mode - 16) * 512 + n0;
#pragma unroll
        for (int c = 0; c < 4; ++c) {
            v4u o0, o1;
            o0.x = pk2(t[0][c] * gv[0][0], t[1][c] * gv[0][1]); o0.y = pk2(t[2][c] * gv[0][2], t[3][c] * gv[0][3]); o0.z = pk2(t[4][c] * gv[1][0], t[5][c] * gv[1][1]); o0.w = pk2(t[6][c] * gv[1][2], t[7][c] * gv[1][3]);
            o1.x = pk2(t[8][c] * gv[2][0], t[9][c] * gv[2][1]); o1.y = pk2(t[10][c] * gv[2][2], t[11][c] * gv[2][3]); o1.z = pk2(t[12][c] * gv[3][0], t[13][c] * gv[3][1]); o1.w = pk2(t[14][c] * gv[3][2], t[15][c] * gv[3][3]);
            bf16* dst = WT + (size_t)(drow0 + 4 * j + c) * K + k0 + 16 * g;
            *(v4u*)dst = o0; *(v4u*)(dst + 8) = o1;
        }
        it += NGW;
    }
    it -= nitems;
}
__device__ __forceinline__ void row_to_bf16_ss(const float* xrow, bf16* orow, pg8::ssq_t* ssp, const int lane) {
    const f32x4* xr = (const f32x4*)xrow + lane; f32x4 v[8]; float s = 0.f;
#pragma unroll
    for (int j = 0; j < 8; ++j) { v[j] = xr[64 * j]; s += (v[j].x * v[j].x + v[j].y * v[j].y) + (v[j].z * v[j].z + v[j].w * v[j].w); }
    s = wave_sum(s);
    v2u* o8 = (v2u*)orow + lane;
#pragma unroll
    for (int j = 0; j < 8; ++j) { v2u w; w.x = pk2(v[j].x, v[j].y); w.y = pk2(v[j].z, v[j].w); o8[64 * j] = w; }
    if (lane == 0) *ssp = pg8::ssq_fix(s);
}

struct Args { const float* in[25]; float* out; unsigned char* ws; int lo, hi; };
constexpr int NPHASES = 43;
#ifndef MK_NG
#define MK_NG 1
#endif
constexpr int NG = MK_NG;

#ifndef MK_ONE_LAUNCH
#define MK_ONE_LAUNCH 1
#endif
#ifndef ATT_REP
#define ATT_REP 1
#endif
#ifndef DIL_XD
#define DIL_XD 1
#endif
#ifndef DIL_ROT
#define DIL_ROT 1
#endif
#ifndef BAR_REP
#define BAR_REP 1
#endif
#ifndef XA_TPC
#define XA_TPC 2
#endif
#ifndef SWA_TIL
#define SWA_TIL 1
#endif
#ifndef SWA_XD
#define SWA_XD 1
#endif
#ifndef PROBE_SAMEKV
#define PROBE_SAMEKV 0
#endif
#ifndef ATT_REP_KIND
#define ATT_REP_KIND -1
#endif
__global__ void __launch_bounds__(NWAVES * 64, 2) mk_fwd(Args args) {
    extern __shared__ __attribute__((aligned(16))) unsigned char lds_raw[];
    LAS unsigned char* lds = (LAS unsigned char*)lds_raw;
    volatile LAS unsigned* MISC = (volatile LAS unsigned*)(lds + MISC_OFF);
    const int wave = __builtin_amdgcn_readfirstlane((int)threadIdx.x >> 6);
#define LANE_ID(v) int v; asm volatile("v_mbcnt_lo_u32_b32 %0, -1, 0\n\tv_mbcnt_hi_u32_b32 %0, -1, %0" : "=v"(v))
    const int G = gridDim.x, bx = blockIdx.x;
    const int vcu = (G % 8 == 0) ? (bx % 8) * (G / 8) + bx / 8 : bx;
    const int gw = vcu * NWAVES + wave, NGW = G * NWAVES;
    const bool grp_ok = (G % (8 * NG) == 0) || NG == 1;
    const int ngr = grp_ok ? NG : 1, XPG = 8 / ngr;
    const int gidx = ngr == 1 ? 0 : (bx % 8) / XPG, lb = ngr == 1 ? bx : (bx / 8) * XPG + (bx % 8) % XPG, GL = G / ngr, nxl = ngr == 1 ? 8 : XPG;
    const int BG = BATCH / ngr, MG = MT / ngr, r0 = gidx * MG, MMG = MMEM / ngr, mr0 = gidx * MMG;
    const int lwv = lb * NWAVES + wave, NLW = GL * NWAVES;
    unsigned char* const ws = args.ws;
    { LANE_ID(l0); const int tid = wave * 64 + l0;
      for (int u = tid; u < (LDS_BYTES - LDSCTL_OFF) / 4; u += NWAVES * 64) ((LAS unsigned*)(lds + LDSCTL_OFF))[u] = 0u;
      __syncthreads();
      (void)xcd_barrier_post((unsigned*)(ws + WS_CTL) + CW_BAR + gidx * XCD_BAR_WORDS, MISC + 8, tid == 0);
      (void)xcd_barrier_post((unsigned*)(ws + WS_CTL) + CW_BAR + NG * XCD_BAR_WORDS, MISC + 12, tid == 0); }
    const int lo = args.lo, hi = args.hi;
    int ph = 0;
#define PH_IF if (ph >= lo && ph < hi)
#define PH_END do { if (ph >= lo && ph + 1 < hi) { XcdBarrier bar_; const bool glob_ = (ph == 0); \
        bar_.bar = (unsigned*)(ws + WS_CTL) + CW_BAR + (glob_ ? NG : gidx) * XCD_BAR_WORDS; bar_.x = xb_xcc_id(); bar_.st = MISC + (glob_ ? 12 : 8); bar_.ng = (unsigned)(glob_ ? G : GL); \
        LANE_ID(lb_); for (int br_ = 0; br_ < BAR_REP; ++br_) xcd_barrier(bar_, wave == 0 && lb_ == 0); } ++ph; } while (0)

#define xout (args.out)
#define xb ((bf16*)(ws + WS_XB))
#define memb ((bf16*)(ws + WS_MEMB))
#define act ((bf16*)(ws + WS_ACT))
#define qbuf ((bf16*)(ws + WS_QKV))
#define kbuf ((bf16*)(ws + WS_QKV + 64 * MiB))
#define vbuf ((bf16*)(ws + WS_QKV + 128 * MiB))
#define obuf ((bf16*)(ws + WS_O))
#define xqbuf ((bf16*)(ws + WS_XQ))
#define xobuf ((bf16*)(ws + WS_XO))
#define kvm ((bf16*)(ws + WS_KVM))
#define ssb ((pg8::ssq_t*)(ws + WS_SS))
#define ssmem ((pg8::ssq_t*)(ws + WS_SSMEM))
#define lseb ((float*)(ws + WS_LSE))
#define tabD ((float*)(ws + WS_TABD))
#define tabS ((float*)(ws + WS_TABS))
#define vl (lds + RING_OFF + wave * 10240)

    PH_IF {
        LANE_ID(lane); const int tid = wave * 64 + lane;
        int it = gw;
        for (int L = 0; L < DEPTH; ++L) {
            unsigned char* wl = ws + WS_W + (size_t)L * WL_STRIDE; const int kind = L % 3, j = L / 3;
            conv_items(it, NGW, args.in[4] + (size_t)L * DM * 2 * FF, DM, 2 * FF, args.in[3] + L * DM, 1.0f, (bf16*)(wl + WL_GU1), 1, lane);
            conv_items(it, NGW, args.in[5] + (size_t)L * FF * DM, FF, DM, nullptr, 0.5f, (bf16*)(wl + WL_DN1), 0, lane);
            conv_items(it, NGW, args.in[22] + (size_t)L * DM * 2 * FF, DM, 2 * FF, args.in[21] + L * DM, 1.0f, (bf16*)(wl + WL_GU2), 1, lane);
            conv_items(it, NGW, args.in[23] + (size_t)L * FF * DM, FF, DM, nullptr, 0.5f, (bf16*)(wl + WL_DN2), 0, lane);
            if (kind == 0) {
                conv_items(it, NGW, args.in[7] + (size_t)j * DM * 6144, DM, 6144, args.in[6] + L * DM, 1.0f, (bf16*)(wl + WL_MQKV), 0, lane);
                conv_items(it, NGW, args.in[8] + (size_t)j * 2048 * DM, 2048, DM, nullptr, 1.0f, (bf16*)(wl + WL_MO), 0, lane);
            } else if (kind == 1) {
                conv_items(it, NGW, args.in[9] + (size_t)j * DM * 4608, DM, 4608, args.in[6] + L * DM, 1.0f, (bf16*)(wl + WL_MQKV), 0, lane);
                conv_items(it, NGW, args.in[10] + (size_t)j * 1536 * DM, 1536, DM, nullptr, 1.0f, (bf16*)(wl + WL_MO), 0, lane);
            } else {
                conv_items(it, NGW, args.in[11] + (size_t)j * DM * 2560, DM, 2560, args.in[6] + L * DM, 1.0f, (bf16*)(wl + WL_MQKV), 0, lane);
                conv_items(it, NGW, args.in[14] + (size_t)j * 2048 * DM, 2048, DM, nullptr, 1.0f, (bf16*)(wl + WL_MO), 0, lane);
            }
            conv_items(it, NGW, args.in[18] + (size_t)L * DM * 512, DM, 512, args.in[16] + L * DM, 1.0f, (bf16*)(wl + WL_XQ), 0, lane);
            conv_items(it, NGW, args.in[19] + (size_t)L * DM * 1024, DM, 1024, args.in[17] + L * DM, 1.0f, (bf16*)(ws + WS_WKV), 16 + L, lane);
            conv_items(it, NGW, args.in[20] + (size_t)L * 512 * DM, 512, DM, nullptr, 1.0f, (bf16*)(wl + WL_XO), 0, lane);
        }
        for (int m = gw; m < MT; m += NGW) row_to_bf16_ss(args.in[0] + (size_t)m * DM, xb + (size_t)m * DM, ssb + m, lane);
        for (int m = gw; m < MMEM; m += NGW) row_to_bf16_ss(args.in[1] + (size_t)m * DM, memb + (size_t)m * DM, ssmem + m, lane);
        const int* pos = (const int*)args.in[2];
        for (int i = bx * (NWAVES * 64) + tid; i < MT * 16; i += G * NWAVES * 64) { const int t = i >> 4, f = i & 15; const float ang = (float)pos[t] * INVF_D[f];
            const double rev = (double)ang * 0.15915494309189535; const float fr = (float)(rev - floor(rev));
            tabD[2 * i] = __builtin_amdgcn_cosf(fr); tabD[2 * i + 1] = __builtin_amdgcn_sinf(fr); }
        for (int i = bx * (NWAVES * 64) + tid; i < MT * 8; i += G * NWAVES * 64) { const int t = i >> 3, f = i & 7; const float ang = (float)pos[t] * INVF_S[f];
            const double rev = (double)ang * 0.15915494309189535; const float fr = (float)(rev - floor(rev));
            tabS[2 * i] = __builtin_amdgcn_cosf(fr); tabS[2 * i + 1] = __builtin_amdgcn_sinf(fr); }
    }
    PH_END;


    for (int s = 0; s < 2 * DEPTH; ++s) {
        const int L = s >> 1, f = s & 1;
        unsigned char* const wl = ws + WS_W + (size_t)L * WL_STRIDE;
        PH_IF {
            pg8::Gemm g{xb + (size_t)r0 * DM, (const bf16*)(wl + (f ? WL_GU2 : WL_GU1)), MG, 2 * FF, DM}; pg8::GroupOrder S; S.init(MG, 2 * FF, GL, lb, nxl);
            pg8::EpiSwiGLU E{act, FF, ssb + (size_t)(4 * L + (f ? 3 : 0)) * MT, r0};
            pg8::gemm_phase<pg8::EpiSwiGLU, pg8::GroupOrder, true, true>(lds + RING_OFF, g, S, E, wave);
        }
        PH_END;
        PH_IF {
            pg8::Gemm g{act + (size_t)r0 * FF, (const bf16*)(wl + (f ? WL_DN2 : WL_DN1)), MG, DM, FF}; pg8::GroupOrder S; S.init(MG, DM, GL, lb, nxl, 4);
            pg8::EpiResid E{xb, ssb + (size_t)(4 * L + (f ? 4 : 1)) * MT, nullptr, r0};
            pg8::gemm_phase<pg8::EpiResid, pg8::GroupOrder, true, true>(lds + RING_OFF, g, S, E, wave);
        }
        PH_END;
        if (f) continue;
        const int kind = L % 3, jm = L / 3;
        PH_IF {
            const int N = kind == 0 ? 6144 : (kind == 1 ? 4608 : 2560);
            pg8::Gemm g{xb + (size_t)r0 * DM, (const bf16*)(wl + WL_MQKV), MG, N, DM}; pg8::GroupOrder S; S.init(MG, N, GL, lb, nxl);
            const pg8::EpiProj E{qbuf, (size_t)(32 * MiB), kind == 1 ? 1536 : 2048, kind == 0 ? 2048 : (kind == 1 ? 1536 : 256), kind == 1 ? 6 : 8, kind == 0 ? 16 : (kind == 1 ? 12 : 9),
                                 ssb + (size_t)(4 * L + 1) * MT, kind == 2 ? args.in[12] + jm * 2560 : nullptr,
                                 kind == 0 ? 0.08838834764831845f : (kind == 1 ? 0.08838834764831845f * 1.4426950408889634f : 0.125f * 1.4426950408889634f),
                                 kind == 0 ? 0 : (kind == 1 ? 128 : 64), kind == 1 ? (const float*)tabD : (const float*)tabS, r0, kind == 0 ? (3 | (4 << 4)) : (kind == 1 ? (3 | (4 << 4) | 256) : (SWA_TIL ? (3 | (4 << 4) | 512) : 0))};
            pg8::gemm_phase<pg8::EpiProj, pg8::GroupOrder, true, true>(lds + RING_OFF, g, S, E, wave);
        }
        PH_END;
        PH_IF for (int rep_ = 0; rep_ < ((ATT_REP_KIND < 0 || ATT_REP_KIND == kind) ? ATT_REP : 1); ++rep_) {
            LANE_ID(lane);
            if (kind == 0) {
                const bool xdeal = (NLW == 256 * nxl) && ((BG * 16) % (2 * nxl) == 0) && (BG * 2048 == 4 * NLW);
                for (int u = lwv; u < BG * 2048; u += NLW) {
                    const int jj = (u / NLW) & 3, wxl = ((lb / nxl) * NWAVES + wave) & 255;
                    const int c = xdeal ? (wxl & 127) : (u & 127), bhl = xdeal ? (lb % nxl) * (BG * 16 / nxl) + 2 * jj + (wxl >> 7) : (u >> 7), a = c & 31, quarter = ((c >> 5) + jj) & 3;
                    const int qb = quarter == 0 ? a : (quarter == 1 ? 63 - a : (quarter == 2 ? 64 + a : 127 - a));
                    const int b = gidx * BG + (bhl >> 4), h = bhl & 15; const size_t base = (size_t)b * SEQ * 2048 + h * 128;
#ifndef MK_NO_SB
                    wa::sb_unit<128>(qbuf + (size_t)(b * 16 + h) * 524288, kbuf + (size_t)(PROBE_SAMEKV && rep_ + 1 < ATT_REP ? 0 : b * 16 + h) * 524288, vbuf + (PROBE_SAMEKV && rep_ + 1 < ATT_REP ? 0 : base), obuf + base + (size_t)(32 * qb) * 2048, 2048, 32 * qb, vl, lane);
#endif
                }
            } else if (kind == 1) {
                const int wpxd = GL / nxl; const bool xd1 = DIL_XD && (GL % nxl == 0) && (wpxd % 16 == 0) && ((BG * 12) % (nxl * (wpxd / 16)) == 0) && (NWAVES == 8);
                for (int u = lwv, kx = 0; u < BG * 1536; u += NLW, ++kx) {
                    const int ppr = wpxd / 16  , jx = lb / nxl;
                    const int idx = xd1 ? (jx & 15) * 8 + wave : (u & 127), hb = xd1 ? ((lb % nxl) * (BG * 12 / nxl) + kx * ppr + (jx >> 4)) : (u >> 7), head = hb % 12, b = gidx * BG + hb / 12, g2 = 2 * (head >> 2), dil = 1 << g2;
                    const int p = idx >> (7 - g2), qb = idx & ((128 >> g2) - 1);
                    const size_t row0 = (size_t)b * SEQ + p; const size_t qrow = row0 + (size_t)(32 * qb) * dil;
                    wa::SmUnit U; U.q = qbuf + qrow * 1536 + head * 128; U.k = kbuf + row0 * 1536 + head * 128; U.v = vbuf + row0 * 1536 + head * 128; U.o = obuf + qrow * 1536 + head * 128;
                    U.qstride = U.kstride = U.vstride = U.ostride = (long)dil * 1536; U.qpos0 = 32 * qb; U.kpos0 = 32 * qb - 128; U.nkeys = SEQ >> g2; U.maxdist = 128; U.causal = 1; U.sink = 0.f;
                    U.lse = lseb + qrow * 12 + head; U.lsestride = (long)dil * 12;
                    U.ntiles = 128 >> g2; U.kt = kbuf + ((size_t)(b * 12 + head) * 128 + (size_t)p * (128 >> g2)) * 4096; U.qt = qbuf + ((size_t)(b * 12 + head) * 128 + (size_t)p * (128 >> g2) + qb) * 4096;
#ifndef MK_NO_DIL
                    wa::sm_unit<128, 5, 1, false, true, true, DIL_ROT != 0>(U, vl, lane);
#endif
                }
            } else {
                const float* sinks = args.in[13] + jm * 32;
                const int wpx = GL / nxl; const bool xd2 = SWA_XD && (GL % nxl == 0) && (128 % wpx == 0) && ((BG * 4) % nxl == 0) && (NWAVES == 8);
                for (int u = lwv, kx = 0; u < BG * 4096; u += NLW, ++kx) {
                    const int ppp = 128 / wpx, pr = (lb % nxl) * (BG * 4 / nxl) + kx / ppp;
                    const int hq = u & 7, qb = xd2 ? (kx % ppp) * wpx + lb / nxl : (u >> 3) & 127, kvh = xd2 ? (pr & 3) : (u >> 10) & 3, b = gidx * BG + (xd2 ? (pr >> 2) : (u >> 12)), head = kvh * 8 + hq;
                    const size_t row0 = (size_t)b * SEQ, qrow = row0 + 32 * qb;
                    wa::SmUnit U; U.q = qbuf + qrow * 2048 + head * 64; U.k = kbuf + row0 * 256 + kvh * 64; U.v = vbuf + row0 * 256 + kvh * 64; U.o = obuf + qrow * 2048 + head * 64;
                    U.qstride = 2048; U.kstride = 256; U.vstride = 256; U.ostride = 2048; U.qpos0 = 32 * qb; U.kpos0 = 32 * qb - 128; U.nkeys = SEQ; U.maxdist = 127; U.causal = 1;
                    U.sink = sinks[head] * 1.4426950408889634f; U.lse = nullptr; U.lsestride = 0; U.qt = qbuf + ((size_t)(b * 32 + head) * 128 + qb) * 2048; U.kt = kbuf + (size_t)(b * 4 + kvh) * 128 * 2048; U.ntiles = 128;
#ifndef MK_NO_SWA
                    wa::sm_unit<64, 5, 1, true, false, SWA_TIL != 0>(U, vl, lane);
#endif
                }
            }
        }
        PH_END;
        if (kind == 1) {
            PH_IF {
                LANE_ID(lane); const int tid = wave * 64 + lane;
                for (int il = lb * (NWAVES * 64) + tid; il < MG * 192; il += GL * NWAVES * 64) { const int i = r0 * 192 + il; const int row = i / 192, c8 = i - row * 192, head = c8 >> 4, g = head >> 2, jj = head & 3;
                    const float l0 = lseb[row * 12 + jj], l1 = lseb[row * 12 + 4 + jj], l2 = lseb[row * 12 + 8 + jj]; const float mx = fmaxf(l0, fmaxf(l1, l2));
                    const float e0 = __expf(l0 - mx), e1 = __expf(l1 - mx), e2 = __expf(l2 - mx); const float al = (g == 0 ? e0 : (g == 1 ? e1 : e2)) / (e0 + e1 + e2);
                    v4u w = *(v4u*)(obuf + (size_t)i * 8); v4u o;
#define SC2(x) pk2(st16::lo(x) * al, st16::hi(x) * al)
                    o.x = SC2(w.x); o.y = SC2(w.y); o.z = SC2(w.z); o.w = SC2(w.w);
#undef SC2
                    *(v4u*)(obuf + (size_t)i * 8) = o; }
            }
            PH_END;
        }
        PH_IF {
            const int Ko = kind == 1 ? 1536 : 2048;
            pg8::Gemm g{obuf + (size_t)r0 * Ko, (const bf16*)(wl + WL_MO), MG, DM, Ko}; pg8::GroupOrder S; S.init(MG, DM, GL, lb, nxl, 4);
            pg8::EpiResid E{xb, ssb + (size_t)(4 * L + 2) * MT, kind == 2 ? args.in[15] + jm * DM : nullptr, r0};
            pg8::gemm_phase<pg8::EpiResid, pg8::GroupOrder, true, true>(lds + RING_OFF, g, S, E, wave);
        }
        PH_END;
        PH_IF {
            if (L == 0 && lb >= GL / 2) {
                pg8::Gemm g{memb + (size_t)mr0 * DM, (const bf16*)(ws + WS_WKV), MMG, 4096, DM}; pg8::GroupOrder S; S.init(MMG, 4096, GL / 2, lb - GL / 2, nxl);
                const pg8::EpiProj E{kvm, (size_t)MMEM * 2048, 2048, 2048, 8, 1 << 30, ssmem, nullptr, 1.0f, 0, nullptr, mr0, 1};
                pg8::gemm_phase<pg8::EpiProj, pg8::GroupOrder, true, true>(lds + RING_OFF, g, S, E, wave);
            }
            pg8::Gemm g{xb + (size_t)r0 * DM, (const bf16*)(wl + WL_XQ), MG, 512, DM}; pg8::GroupOrder S; S.init(MG, 512, GL, lb, nxl);
            const pg8::EpiProj E{xqbuf, 0, 512, 512, 1 << 30, 1 << 30, ssb + (size_t)(4 * L + 2) * MT, nullptr, 0.08838834764831845f * 1.4426950408889634f, 0, nullptr, r0, 1 | (4 << 4)};
            pg8::gemm_phase<pg8::EpiProj, pg8::GroupOrder, true, true>(lds + RING_OFF, g, S, E, wave);
        }
        PH_END;
        PH_IF for (int rep_ = 0; rep_ < ((ATT_REP_KIND < 0 || ATT_REP_KIND == 3) ? ATT_REP : 1); ++rep_) {
            LANE_ID(lane);
            for (int u = lwv; u < BG * 512; u += NLW) {
                const int qb = u & 127, h = (u >> 7) & 3, b = gidx * BG + (u >> 9); const size_t qrow = (size_t)b * SEQ + 32 * qb;
                wa::SmUnit U; U.q = nullptr; U.k = nullptr; U.v = kvm + (size_t)MMEM * 2048 + (size_t)b * NMEM * 2048 + L * 512 + h * 128; U.o = xobuf + qrow * 512 + h * 128;
                U.qt = xqbuf + ((size_t)(b * 4 + h) * 128 + qb) * 4096; U.kt = kvm + (size_t)(b * 16 + L * 4 + h) * 8 * 4096; U.ntiles = 8;
                U.qstride = 512; U.kstride = 2048; U.vstride = 2048; U.ostride = 512; U.qpos0 = 32 * qb; U.kpos0 = 0; U.nkeys = NMEM; U.maxdist = 1 << 30; U.causal = 0; U.sink = 0.f; U.lse = nullptr; U.lsestride = 0;
#ifndef MK_NO_XA
                wa::sm_unit<128, XA_TPC, 8 / XA_TPC, false, false, true>(U, vl, lane);
#endif
            }
        }
        PH_END;
        PH_IF {
            pg8::Gemm g{xobuf + (size_t)r0 * 512, (const bf16*)(wl + WL_XO), MG, DM, 512}; pg8::GroupOrder S; S.init(MG, DM, GL, lb, nxl, 4);
            pg8::EpiResid E{xb, ssb + (size_t)(4 * L + 3) * MT, nullptr, r0};
            pg8::gemm_phase<pg8::EpiResid, pg8::GroupOrder, true, true>(lds + RING_OFF, g, S, E, wave);
        }
        PH_END;
    }
    PH_IF {
        LANE_ID(lane);
        const pg8::ssq_t* ssf = ssb + (size_t)16 * MT; const f32x4* gn = (const f32x4*)args.in[24] + lane;
        for (int m = r0 + lwv; m < r0 + MG; m += NLW) { const float ri = pg8::rinv_of(ssf, m); f32x4* xr = (f32x4*)(xout + (size_t)m * DM) + lane; const v2u* xi = (const v2u*)(xb + (size_t)m * DM) + lane;
#pragma unroll
            for (int j = 0; j < 8; ++j) { const v2u w = xi[64 * j]; const f32x4 gg = gn[64 * j];
                f32x4 v; v[0] = st16::lo(w.x); v[1] = st16::hi(w.x); v[2] = st16::lo(w.y); v[3] = st16::hi(w.y);
                xr[64 * j] = v * ri * gg; } }
    }
    PH_END;
#undef PH_IF
#undef PH_END
}

extern "C" void kernel_launch(void* const* d_in, const int* in_sizes, int n_in, void* d_out, int out_size, void* d_ws, size_t ws_size, hipStream_t stream) {
    static int grid = 0;
    if (grid == 0) {
        if (n_in != 25 || out_size != MT * DM || ws_size < WS_END) { fprintf(stderr, "kernel_launch: unexpected shapes (n_in %d, out %d, ws %zu < %zu); nothing launched\n", n_in, out_size, ws_size, (size_t)WS_END); grid = -1; return; }
        int dev = 0, cus = 0, per_cu = 0;
        if (hipGetDevice(&dev) != hipSuccess || hipDeviceGetAttribute(&cus, hipDeviceAttributeMultiprocessorCount, dev) != hipSuccess) { fprintf(stderr, "kernel_launch: device query failed\n"); grid = -1; return; }
        if (hipFuncSetAttribute((const void*)mk_fwd, hipFuncAttributeMaxDynamicSharedMemorySize, LDS_BYTES) != hipSuccess) { fprintf(stderr, "kernel_launch: hipFuncSetAttribute failed\n"); grid = -1; return; }
        if (hipOccupancyMaxActiveBlocksPerMultiprocessor(&per_cu, (const void*)mk_fwd, NWAVES * 64, LDS_BYTES) != hipSuccess || per_cu < 1)
            fprintf(stderr, "kernel_launch: note: occupancy query reports %d workgroups per CU\n", per_cu);
        (void)hipGetLastError();
        grid = cus;
    }
    if (grid < 0) return;
    if (hipMemsetAsync((char*)d_ws + WS_CTL, 0, ZERO_BYTES, stream) != hipSuccess) { fprintf(stderr, "kernel_launch: memset failed\n"); return; }
    Args a{};
    for (int i = 0; i < 25; ++i) a.in[i] = (const float*)d_in[i];
    a.out = (float*)d_out; a.ws = (unsigned char*)d_ws;
#if MK_ONE_LAUNCH
    a.lo = 0; a.hi = NPHASES;
    hipLaunchKernelGGL(mk_fwd, dim3(grid), dim3(NWAVES * 64), LDS_BYTES, stream, a);
#else
    for (int p = 0; p < NPHASES; ++p) { a.lo = p; a.hi = p + 1; hipLaunchKernelGGL(mk_fwd, dim3(grid), dim3(NWAVES * 64), LDS_BYTES, stream, a); }
#endif
    const hipError_t le = hipPeekAtLastError();
    if (le != hipSuccess) fprintf(stderr, "kernel_launch: launch failed: %s\n", hipGetErrorName(le));
}
```

```cpp
#include <hip/hip_runtime.h>
#include <cstdio>
#include <cstdint>
#include <cmath>
#ifndef MK_F16
#define MK_F16 0
#endif
namespace st16 {
typedef short s16x8 __attribute__((ext_vector_type(8)));
typedef float v4f __attribute__((ext_vector_type(4)));
typedef float v16f __attribute__((ext_vector_type(16)));
#if MK_F16
typedef _Float16 h16x8 __attribute__((ext_vector_type(8)));
typedef _Float16 h16x2 __attribute__((ext_vector_type(2)));
typedef float v2f __attribute__((ext_vector_type(2)));
__device__ __forceinline__ unsigned pack(float lo, float hi) { unsigned r; asm volatile("v_cvt_pk_f16_f32 %0, %1, %2" : "=v"(r) : "v"(lo), "v"(hi)); return r; }
__device__ __forceinline__ float lo(unsigned w) { return (float)__builtin_bit_cast(h16x2, w)[0]; }
__device__ __forceinline__ float hi(unsigned w) { return (float)__builtin_bit_cast(h16x2, w)[1]; }
__device__ __forceinline__ v4f mfma16(s16x8 a, s16x8 b, v4f c) { return __builtin_amdgcn_mfma_f32_16x16x32_f16(__builtin_bit_cast(h16x8, a), __builtin_bit_cast(h16x8, b), c, 0, 0, 0); }
__device__ __forceinline__ v16f mfma32(s16x8 a, s16x8 b, v16f c) { return __builtin_amdgcn_mfma_f32_32x32x16_f16(__builtin_bit_cast(h16x8, a), __builtin_bit_cast(h16x8, b), c, 0, 0, 0); }
#else
__device__ __forceinline__ unsigned pack(float lo, float hi) { unsigned r; asm volatile("v_cvt_pk_bf16_f32 %0, %1, %2" : "=v"(r) : "v"(lo), "v"(hi)); return r; }
__device__ __forceinline__ float lo(unsigned w) { return __uint_as_float(w << 16); }
__device__ __forceinline__ float hi(unsigned w) { return __uint_as_float(w & 0xffff0000u); }
__device__ __forceinline__ v4f mfma16(s16x8 a, s16x8 b, v4f c) { return __builtin_amdgcn_mfma_f32_16x16x32_bf16(a, b, c, 0, 0, 0); }
__device__ __forceinline__ v16f mfma32(s16x8 a, s16x8 b, v16f c) { return __builtin_amdgcn_mfma_f32_32x32x16_bf16(a, b, c, 0, 0, 0); }
#endif
}

namespace pg8 {
#define PG8_LAS __attribute__((address_space(3)))
typedef unsigned short bf16_t;
typedef short bf16x8 __attribute__((ext_vector_type(8)));
typedef float f32x4 __attribute__((ext_vector_type(4)));
typedef unsigned u32x4 __attribute__((ext_vector_type(4)));
constexpr int BM = 256, BK = 64, HALF = 128, HTB = HALF * BK * 2  , STAGE_BYTES = 8 * HTB, NXCD = 8, WGM = 8;

__host__ __device__ __forceinline__ int lds_byte(int r, int c) { const int st = (r >> 4) * 2 + (c >> 5), rr = r & 15, cc = c & 31, ob = rr * 64 + cc * 2; return st * 1024 + (ob ^ (((ob >> 9) & 1) << 5)); }
__host__ __device__ __forceinline__ void stage_rc(int b, int& R, int& C) { const int st = b / 1024, sb = b % 1024, swz = sb ^ (((sb >> 9) & 1) << 5); R = (st >> 1) * 16 + swz / 64; C = (st & 1) * 32 + (swz % 64) / 2; }
__host__ __device__ __forceinline__ int perm32(int rho) { const int n = rho >> 4, i = rho & 15; return 8 * (i >> 2) + 4 * n + (i & 3); }

struct Unit { int pm, pn; };
struct Gemm { const bf16_t* A; const bf16_t* Bt; int M, N, K; };

struct StaticOrder {
    int nM, nN, nwg, G, c;
    __host__ __device__ void init(int M, int N, int G_, int c_) { nM = M / BM; nN = N / BM; nwg = nM * nN; G = G_; c = c_; }
    __host__ __device__ bool next(int i, Unit& u) const {
        const long L = (long)i * G + c; if (L >= nwg) return false;
        int wgid = (int)L; { const int q = nwg / NXCD, r = nwg % NXCD, xcd = wgid % NXCD, off = wgid / NXCD; wgid = (xcd < r ? xcd * (q + 1) : r * (q + 1) + (xcd - r) * q) + off; }
        const int nig = WGM * nN, gid = wgid / nig, fm = gid * WGM, gsz = (nM - fm) < WGM ? (nM - fm) : WGM;
        u.pm = fm + ((wgid % nig) % gsz); u.pn = (wgid % nig) / gsz; return true;
    }
    __device__ __forceinline__ void a_ready(const Unit&) const {}
    __device__ __forceinline__ void done(const Unit&) const {}
};
struct GroupOrder {
    int nM, nN, nwg, G, c, nx, wgm;
    __host__ __device__ void init(int M, int N, int G_, int c_, int nx_, int wgm_ = WGM) { nM = M / BM; nN = N / BM; nwg = nM * nN; G = G_; c = c_; nx = nx_; wgm = wgm_; }
    __host__ __device__ bool next(int i, Unit& u) const {
        const long L = (long)i * G + c; if (L >= nwg) return false;
        int wgid = (int)L; { const int q = nwg / nx, r = nwg % nx, xcd = wgid % nx, off = wgid / nx; wgid = (xcd < r ? xcd * (q + 1) : r * (q + 1) + (xcd - r) * q) + off; }
        const int nig = wgm * nN, gid = wgid / nig, fm = gid * wgm, gsz = (nM - fm) < wgm ? (nM - fm) : wgm;
        u.pm = fm + ((wgid % nig) % gsz); u.pn = (wgid % nig) / gsz; return true;
    }
    __device__ __forceinline__ void a_ready(const Unit&) const {}
    __device__ __forceinline__ void done(const Unit&) const {}
};

__device__ __forceinline__ unsigned cvt_pk_bf16(float lo, float hi) { return st16::pack(lo, hi); }
typedef float f32x2 __attribute__((ext_vector_type(2)));
constexpr float RMS_EPS = 1e-6f, INV_D = 1.0f / 2048.0f, LOG2E = 1.4426950408889634f;
typedef unsigned long long ssq_t;
constexpr float SSQ_SCALE = 16777216.0f;
__device__ __forceinline__ ssq_t ssq_fix(float s) { return (ssq_t)(s * SSQ_SCALE + 0.5f); }
__device__ __forceinline__ float rinv_of(const ssq_t* ss, int row) { const ssq_t s = ss[row]; const float sf = (float)(unsigned)(s >> 32) * 4294967296.0f + (float)(unsigned)s;
    return __builtin_amdgcn_rsqf(sf * (INV_D / SSQ_SCALE) + RMS_EPS); }

struct PreRinv { float ri[8]; };
struct PreNone {};
#ifndef EPI_REP
#define EPI_REP 1
#endif
struct EpiSwiGLU {
    static constexpr bool PERM = true, AFTER_DRAIN = false; static constexpr int REP = EPI_REP;
    bf16_t* O; int ldc; const ssq_t* ss; int roff;
    typedef PreNone Pre;
    __device__ __forceinline__ void prefetch(Pre&, const Unit&, int, int, int, int) const {}
    __device__ __forceinline__ void operator()(const f32x4 (&acc)[2][2][4][2], const Unit& u, int wr, int wc, int fr, int fq, const Pre&) const {
        const int row0 = roff + u.pm * BM + wr * 64 + fr, col0 = u.pn * HALF + wc * 32 + 8 * fq;
#pragma unroll
        for (int ai = 0; ai < 2; ++ai)
#pragma unroll
            for (int m = 0; m < 4; ++m) { const int r = row0 + ai * HALF + m * 16; const float ri = rinv_of(ss, r), rl = ri * (-LOG2E), rq = ri * ri;
                float h[8];
#pragma unroll
                for (int n = 0; n < 2; ++n)
#pragma unroll
                    for (int j = 0; j < 4; j += 2) {
                        const f32x2 g = (f32x2){acc[ai][0][m][n][j], acc[ai][0][m][n][j + 1]}, uu = (f32x2){acc[ai][1][m][n][j], acc[ai][1][m][n][j + 1]};
                        const f32x2 t = g * rl; f32x2 e; e.x = __builtin_amdgcn_exp2f(t.x); e.y = __builtin_amdgcn_exp2f(t.y);
                        const f32x2 d = e + 1.0f; f32x2 rc; rc.x = __builtin_amdgcn_rcpf(d.x); rc.y = __builtin_amdgcn_rcpf(d.y);
                        const f32x2 hv = (g * uu) * (rc * rq); h[4 * n + j] = hv.x; h[4 * n + j + 1] = hv.y; }
                u32x4 w; w.x = cvt_pk_bf16(h[0], h[1]); w.y = cvt_pk_bf16(h[2], h[3]); w.z = cvt_pk_bf16(h[4], h[5]); w.w = cvt_pk_bf16(h[6], h[7]);
                *(u32x4*)(O + (size_t)r * ldc + col0) = w; }
    }
};

struct EpiResid {
    static constexpr bool PERM = true, AFTER_DRAIN = false; static constexpr int REP = 1;
    bf16_t* xb; ssq_t* ssn; const float* bias; int roff;
    typedef PreNone Pre;
    __device__ __forceinline__ void prefetch(Pre&, const Unit&, int, int, int, int) const {}
    __device__ __forceinline__ void operator()(const f32x4 (&acc)[2][2][4][2], const Unit& u, int wr, int wc, int fr, int fq, const Pre&) const {
        const int row0 = roff + u.pm * BM + wr * 64 + fr, col0 = u.pn * BM + wc * 32 + 8 * fq;
        f32x4 bv[2][2];
#pragma unroll
        for (int bj = 0; bj < 2; ++bj)
#pragma unroll
            for (int n = 0; n < 2; ++n) bv[bj][n] = bias ? *(const f32x4*)(bias + col0 + bj * HALF + 4 * n) : (f32x4){0.f, 0.f, 0.f, 0.f};
#pragma unroll
        for (int ai = 0; ai < 2; ++ai)
#pragma unroll
            for (int m = 0; m < 4; ++m) { const int r = row0 + ai * HALF + m * 16; float sq = 0.f;
#pragma unroll
                for (int bj = 0; bj < 2; ++bj) { bf16_t* p = xb + (size_t)r * 2048 + col0 + bj * HALF;
                    const u32x4 xo = *(const u32x4*)p;
                    f32x4 v0, v1;
                    v0[0] = st16::lo(xo.x); v0[1] = st16::hi(xo.x); v0[2] = st16::lo(xo.y); v0[3] = st16::hi(xo.y);
                    v1[0] = st16::lo(xo.z); v1[1] = st16::hi(xo.z); v1[2] = st16::lo(xo.w); v1[3] = st16::hi(xo.w);
                    v0 = v0 + acc[ai][bj][m][0] + bv[bj][0]; v1 = v1 + acc[ai][bj][m][1] + bv[bj][1];
                    u32x4 w; w.x = cvt_pk_bf16(v0[0], v0[1]); w.y = cvt_pk_bf16(v0[2], v0[3]); w.z = cvt_pk_bf16(v1[0], v1[1]); w.w = cvt_pk_bf16(v1[2], v1[3]);
                    *(u32x4*)p = w;
                    sq += (v0[0] * v0[0] + v0[1] * v0[1]) + (v0[2] * v0[2] + v0[3] * v0[3]) + (v1[0] * v1[0] + v1[1] * v1[1]) + (v1[2] * v1[2] + v1[3] * v1[3]); }
                sq += __shfl_xor(sq, 16); sq += __shfl_xor(sq, 32);
                if (fq == 0) atomicAdd(ssn + r, ssq_fix(sq)); }
    }
};

struct EpiProj {
    static constexpr bool PERM = true, AFTER_DRAIN = false; static constexpr int REP = 1;
    bf16_t* d0; size_t tstride; int ld0, ld12, t1, t2; const ssq_t* ss; const float* bias; float qscale; int hd; const float* rtab; int roff; int tl;
    typedef PreNone Pre;
    __device__ __forceinline__ void prefetch(Pre&, const Unit&, int, int, int, int) const {}
    __device__ __forceinline__ void operator()(const f32x4 (&acc)[2][2][4][2], const Unit& u, int wr, int wc, int fr, int fq, const Pre&) const {
        const int pn = u.pn; const int tsel = pn >= t2 ? 2 : (pn >= t1 ? 1 : 0);
        bf16_t* base = d0 + (size_t)tsel * tstride; const int ld = tsel == 0 ? ld0 : ld12; const int tf = pn >= t2 ? t2 : (pn >= t1 ? t1 : 0);
        const float sc = tsel == 0 ? qscale : 1.0f;
        const int row0 = roff + u.pm * BM + wr * 64 + fr, col0 = (pn - tf) * BM + wc * 32 + 8 * fq, gcol0 = pn * BM + wc * 32 + 8 * fq;
        const bool rotw = (hd != 0) && (tsel < 2) && (hd == 128 ? (wc == 0) : ((wc & 1) == 0));
        const bool rotl = (hd == 128) ? true : (fq < 2);
        const int half = hd >> 3, xr = hd >> 2;
        const int ii0 = (hd == 128) ? 8 * (fq & 1) : 0;
        const float sgn = ((hd == 128) ? (fq < 2) : (fq == 0)) ? -1.0f : 1.0f;
#pragma unroll
        for (int ai = 0; ai < 2; ++ai)
#pragma unroll
            for (int m = 0; m < 4; ++m) { const int r = row0 + ai * HALF + m * 16; const float ri = rinv_of(ss, r);
                f32x4 cs[4];
                if (rotw) { const f32x4* tp = (const f32x4*)(rtab + ((size_t)r * half + ii0) * 2);
#pragma unroll
                    for (int q = 0; q < 4; ++q) cs[q] = tp[q]; }
#pragma unroll
                for (int bj = 0; bj < 2; ++bj) { float v[8];
                    f32x4 b0 = (f32x4){0.f, 0.f, 0.f, 0.f}, b1 = b0;
                    if (bias) { b0 = *(const f32x4*)(bias + gcol0 + bj * HALF); b1 = *(const f32x4*)(bias + gcol0 + bj * HALF + 4); }
#pragma unroll
                    for (int j = 0; j < 4; ++j) { v[j] = acc[ai][bj][m][0][j] * ri + b0[j]; v[4 + j] = acc[ai][bj][m][1][j] * ri + b1[j]; }
                    if (rotw) {
#pragma unroll
                        for (int i = 0; i < 8; ++i) { const float o = __shfl_xor(v[i], xr); const float c = cs[i >> 1][2 * (i & 1)], s = cs[i >> 1][2 * (i & 1) + 1];
                            const float nv = v[i] * c + sgn * o * s; v[i] = rotl ? nv : v[i]; } }
                    u32x4 w; w.x = cvt_pk_bf16(v[0] * sc, v[1] * sc); w.y = cvt_pk_bf16(v[2] * sc, v[3] * sc); w.z = cvt_pk_bf16(v[4] * sc, v[5] * sc); w.w = cvt_pk_bf16(v[6] * sc, v[7] * sc);
                    const int cq = col0 + bj * HALF;
                    unsigned off = (unsigned)r * (unsigned)ld + (unsigned)cq;
                    if ((tl >> tsel) & 1) {
                        const int hdl = (tl & 512) ? 6 : 7;
                        const int lsq = 8 + ((tl >> 4) & 15), H = ld >> hdl, head = __builtin_amdgcn_readfirstlane(cq >> hdl), cc = cq & ((1 << hdl) - 1);
                        const int l2d = (tl & 256) ? 2 * (head >> 2) : 0;
                        const unsigned b = (unsigned)r >> lsq, pos = (unsigned)r & ((1u << lsq) - 1u), a = pos >> l2d, p = pos & ((1u << l2d) - 1u), ft = (p << (lsq - l2d - 5)) + (a >> 5);
                        off = ((((b * (unsigned)H + (unsigned)head) << (lsq - 5)) + ft) * (unsigned)(1 << (hdl - 4)) + (unsigned)(cc >> 4)) * 512u + (unsigned)(((cc >> 3) & 1) * 32) * 8u + (a & 31u) * 8u; }
                    *(u32x4*)(base + off) = w; } }
    }
};

#ifndef ZERO_REP
#define ZERO_REP 1
#endif
template <class Epi, class Sched, bool ALIGN_EPI = false, bool SP2 = false>
__device__ __forceinline__ void gemm_phase(PG8_LAS unsigned char* lds, const Gemm g, const Sched& S, const Epi& E, const int wave_in) {
    int tid0; asm volatile("v_mbcnt_lo_u32_b32 %0, -1, 0\n\tv_mbcnt_hi_u32_b32 %0, -1, %0" : "=v"(tid0)); tid0 += wave_in * 64;
    const int tid = tid0, wid = __builtin_amdgcn_readfirstlane(tid >> 6), lane = tid & 63, wr = wid >> 2, wc = wid & 3, fr = lane & 15, fq = lane >> 4;
    const int K = g.K, nt = K / BK;
    unsigned voffA[2], voffB[2];
#pragma unroll
    for (int i = 0; i < 2; ++i) { int R, C; stage_rc(tid * 16 + i * 8192, R, C); const int Rb = Epi::PERM ? ((R & ~31) + perm32(R & 31)) : R;
        voffA[i] = (unsigned)(R * K + C) * 2u; voffB[i] = (unsigned)(Rb * K + C) * 2u; }
    const size_t kstep = (size_t)(BK * 2);
    const size_t hstep = (size_t)HALF * K * 2;
    const size_t tstep = 2 * hstep;
    const unsigned ldsw = (unsigned)wid * 1024u;
    const int aoff = lds_byte(wr * 64 + fr, fq * 8), boff = lds_byte(wc * 32 + fr, fq * 8);
#define PG8_SA(b, h) (((b) * 2 + (h)) * HTB)
#define PG8_SB(b, h) ((4 + (b) * 2 + (h)) * HTB)
#define PG8_STAGE(bufoff, gbase, voff) do { _Pragma("unroll") for (int _i = 0; _i < 2; ++_i) \
        __builtin_amdgcn_global_load_lds((const unsigned*)((const char*)(gbase) + (voff)[_i]), (PG8_LAS unsigned*)(lds + (bufoff) + ldsw + _i * 8192), 16, 0, 0); } while (0)
#define PG8_LDA(dst, b, h) do { _Pragma("unroll") for (int m = 0; m < 4; ++m) _Pragma("unroll") for (int k = 0; k < 2; ++k) dst[m][k] = *(const PG8_LAS bf16x8*)(lds + PG8_SA(b, h) + aoff + m * 2048 + k * 1024); } while (0)
#define PG8_LDB(dst, b, h) do { _Pragma("unroll") for (int n = 0; n < 2; ++n) _Pragma("unroll") for (int k = 0; k < 2; ++k) dst[n][k] = *(const PG8_LAS bf16x8*)(lds + PG8_SB(b, h) + boff + n * 2048 + k * 1024); } while (0)
#define PG8_MMA(ai, bj, At, Bt) do { __builtin_amdgcn_s_setprio(1); _Pragma("unroll") for (int m = 0; m < 4; ++m) _Pragma("unroll") for (int n = 0; n < 2; ++n) _Pragma("unroll") for (int k = 0; k < 2; ++k) \
        acc[ai][bj][m][n] = st16::mfma16(Bt[n][k], At[m][k], acc[ai][bj][m][n]); __builtin_amdgcn_s_setprio(0); } while (0)
#define PG8_WAIT_V(n) asm volatile("s_waitcnt vmcnt(" #n ")" ::: "memory")
#define PG8_WAIT_L(n) asm volatile("s_waitcnt lgkmcnt(" #n ")" ::: "memory")
#define PG8_BAR __builtin_amdgcn_s_barrier()
#define PG8_SCHED __builtin_amdgcn_sched_barrier(0)
    typedef float f32x2z __attribute__((ext_vector_type(2)));
    Unit cur, nxt; int ui = 0;
    if (!S.next(0, cur)) return;
    f32x4 acc[2][2][4][2];
    typename Epi::Pre pre;
#pragma unroll
    for (int a = 0; a < 2; ++a)
#pragma unroll
        for (int b = 0; b < 2; ++b)
#pragma unroll
            for (int m = 0; m < 4; ++m)
#pragma unroll
                for (int n = 0; n < 2; ++n) { f32x2z z0_, z1_; asm volatile("v_mov_b64 %0, 0" : "=v"(z0_)); asm volatile("v_mov_b64 %0, 0" : "=v"(z1_));
                    acc[a][b][m][n] = (f32x4){z0_[0], z0_[1], z1_[0], z1_[1]}; }
    bf16x8 At[4][2], B0[2][2], B1[2][2];
    const char* cA = (const char*)g.A + (size_t)cur.pm * tstep; const char* cB = (const char*)g.Bt + (size_t)cur.pn * tstep;
    S.a_ready(cur);
    if constexpr (SP2) {
        PG8_STAGE(PG8_SB(0, 0), cB, voffB); PG8_STAGE(PG8_SB(0, 1), cB + hstep, voffB); PG8_STAGE(PG8_SA(0, 0), cA, voffA); PG8_STAGE(PG8_SA(0, 1), cA + hstep, voffA);
        if (wr == 1) PG8_BAR;
        PG8_WAIT_V(2); PG8_BAR;
        PG8_STAGE(PG8_SB(1, 0), cB + kstep, voffB); PG8_STAGE(PG8_SA(1, 0), cA + kstep, voffA); PG8_STAGE(PG8_SB(1, 1), cB + hstep + kstep, voffB);
        PG8_WAIT_V(6); PG8_BAR;
    } else {
        PG8_STAGE(PG8_SB(0, 0), cB, voffB); PG8_STAGE(PG8_SA(0, 0), cA, voffA); PG8_STAGE(PG8_SB(0, 1), cB + hstep, voffB); PG8_STAGE(PG8_SA(0, 1), cA + hstep, voffA);
        if (wr == 1) PG8_BAR;
        PG8_WAIT_V(4); PG8_BAR;
        PG8_STAGE(PG8_SB(1, 0), cB + kstep, voffB); PG8_STAGE(PG8_SA(1, 0), cA + kstep, voffA); PG8_STAGE(PG8_SB(1, 1), cB + hstep + kstep, voffB);
        PG8_WAIT_V(6); PG8_BAR;
    }
    for (;;) {
        const bool has_next = S.next(ui + 1, nxt);
        const char* nA = has_next ? (const char*)g.A + (size_t)nxt.pm * tstep : cA; const char* nB = has_next ? (const char*)g.Bt + (size_t)nxt.pn * tstep : cB;
        for (int t = 0; t < nt; t += 2) {
            const bool last = (t == nt - 2);
            const char* a1 = cA + (size_t)(t + 1) * kstep;
            const char* a2 = last ? nA : cA + (size_t)(t + 2) * kstep; const char* b2 = last ? nB : cB + (size_t)(t + 2) * kstep;
            const char* a3 = a2 + kstep; const char* b3 = b2 + kstep;
            if (last && has_next) S.a_ready(nxt);
            if (last) E.prefetch(pre, cur, wr, wc, fr, fq);
            if constexpr (SP2) {
            PG8_LDB(B0, 0, 0); PG8_LDB(B1, 0, 1); PG8_SCHED; PG8_LDA(At, 0, 0); PG8_STAGE(PG8_SA(1, 1), a1 + hstep, voffA);
            PG8_WAIT_V(8); PG8_WAIT_L(0); PG8_BAR; PG8_MMA(0, 0, At, B0); PG8_MMA(0, 1, At, B1); PG8_BAR; PG8_SCHED;
            PG8_LDA(At, 0, 1); PG8_STAGE(PG8_SB(0, 0), b2, voffB); PG8_STAGE(PG8_SB(0, 1), b2 + hstep, voffB); PG8_STAGE(PG8_SA(0, 0), a2, voffA);
            PG8_WAIT_V(8); PG8_WAIT_L(0); PG8_BAR; PG8_MMA(1, 0, At, B0); PG8_MMA(1, 1, At, B1); PG8_BAR; PG8_SCHED;
            PG8_LDB(B0, 1, 0); PG8_LDB(B1, 1, 1); PG8_SCHED; PG8_LDA(At, 1, 0); PG8_STAGE(PG8_SA(0, 1), a2 + hstep, voffA);
            PG8_WAIT_V(8); PG8_WAIT_L(0); PG8_BAR; PG8_MMA(0, 0, At, B0); PG8_MMA(0, 1, At, B1); PG8_BAR; PG8_SCHED;
            PG8_LDA(At, 1, 1); PG8_STAGE(PG8_SB(1, 0), b3, voffB); PG8_STAGE(PG8_SB(1, 1), b3 + hstep, voffB); PG8_STAGE(PG8_SA(1, 0), a3, voffA);
            PG8_WAIT_V(8); PG8_WAIT_L(0); PG8_BAR; PG8_MMA(1, 0, At, B0); PG8_MMA(1, 1, At, B1); PG8_BAR; PG8_SCHED;
            } else {
            PG8_LDB(B0, 0, 0); PG8_SCHED; PG8_LDA(At, 0, 0); PG8_STAGE(PG8_SA(1, 1), a1 + hstep, voffA);
            PG8_WAIT_L(8); PG8_BAR; PG8_WAIT_L(0); PG8_MMA(0, 0, At, B0); PG8_BAR; PG8_SCHED;
            PG8_LDB(B1, 0, 1); PG8_STAGE(PG8_SB(0, 0), b2, voffB);
            PG8_BAR; PG8_WAIT_L(0); PG8_MMA(0, 1, At, B1); PG8_BAR;
            PG8_LDA(At, 0, 1); PG8_STAGE(PG8_SA(0, 0), a2, voffA);
            PG8_BAR; PG8_WAIT_L(0); PG8_MMA(1, 0, At, B0); PG8_BAR; PG8_SCHED;
            PG8_STAGE(PG8_SB(0, 1), b2 + hstep, voffB);
            PG8_WAIT_V(6); PG8_BAR; PG8_MMA(1, 1, At, B1); PG8_BAR;
            PG8_LDB(B0, 1, 0); PG8_SCHED; PG8_LDA(At, 1, 0); PG8_STAGE(PG8_SA(0, 1), a2 + hstep, voffA);
            PG8_WAIT_L(8); PG8_BAR; PG8_WAIT_L(0); PG8_MMA(0, 0, At, B0); PG8_BAR; PG8_SCHED;
            PG8_LDB(B1, 1, 1); PG8_STAGE(PG8_SB(1, 0), b3, voffB);
            PG8_BAR; PG8_WAIT_L(0); PG8_MMA(0, 1, At, B1); PG8_BAR;
            PG8_LDA(At, 1, 1); PG8_STAGE(PG8_SA(1, 0), a3, voffA);
            PG8_BAR; PG8_WAIT_L(0); PG8_MMA(1, 0, At, B0); PG8_BAR; PG8_SCHED;
            PG8_STAGE(PG8_SB(1, 1), b3 + hstep, voffB);
            PG8_WAIT_V(6); PG8_BAR; PG8_MMA(1, 1, At, B1); PG8_BAR;
            }
        }
        if constexpr (ALIGN_EPI) { if (wr == 0) PG8_BAR; }
        if constexpr (!Epi::AFTER_DRAIN) { for (int er_ = 0; er_ < Epi::REP; ++er_) E(acc, cur, wr, wc, fr, fq, pre); S.done(cur); }
        if (!has_next) break;
        for (int zr_ = 0; zr_ < ZERO_REP; ++zr_)
#pragma unroll
        for (int a = 0; a < 2; ++a)
#pragma unroll
            for (int b = 0; b < 2; ++b)
#pragma unroll
                for (int m = 0; m < 4; ++m)
#pragma unroll
                    for (int n = 0; n < 2; ++n) { f32x2z z0_, z1_; asm volatile("v_mov_b64 %0, 0" : "=v"(z0_)); asm volatile("v_mov_b64 %0, 0" : "=v"(z1_));
                    acc[a][b][m][n] = (f32x4){z0_[0], z0_[1], z1_[0], z1_[1]}; }
        cur = nxt; cA = nA; cB = nB; ++ui;
        if constexpr (ALIGN_EPI) { if (wr == 1) PG8_BAR; }
    }
    PG8_WAIT_V(0);
    if constexpr (!ALIGN_EPI) { if (wr == 0) PG8_BAR; }
    PG8_BAR;
    if constexpr (Epi::AFTER_DRAIN) { E.fused(acc, cur, wr, wc, fr, fq, lds, wid, lane); S.done(cur); }
#undef PG8_SA
#undef PG8_SB
#undef PG8_STAGE
#undef PG8_LDA
#undef PG8_LDB
#undef PG8_MMA
#undef PG8_WAIT_V
#undef PG8_WAIT_L
#undef PG8_BAR
#undef PG8_SCHED
}
}

namespace wa {
#ifndef WA_MASK_SKIP
#define WA_MASK_SKIP 1
#endif
#define WA_LAS __attribute__((address_space(3)))
typedef unsigned short bf16_t;
typedef short bf16x8 __attribute__((ext_vector_type(8)));
typedef short s16x4 __attribute__((ext_vector_type(4)));
typedef float f32x16 __attribute__((ext_vector_type(16)));
typedef float f32x4 __attribute__((ext_vector_type(4)));
typedef unsigned u32x4 __attribute__((ext_vector_type(4)));
typedef unsigned u32x2 __attribute__((ext_vector_type(2)));
constexpr float LOG2E = 1.4426950408889634f, LN2 = 0.6931471805599453f;
__device__ __forceinline__ unsigned cvtpk(float lo, float hi) { return st16::pack(lo, hi); }
__device__ __forceinline__ s16x4 vtr(const WA_LAS unsigned char* p) { return __builtin_bit_cast(s16x4, __builtin_amdgcn_ds_read_tr16_b64_v4i16((WA_LAS s16x4*)p)); }
__device__ __forceinline__ int kofs(int reg, int hh) { return (reg & 3) + 8 * (reg >> 2) + 4 * hh; }

template <int HD> struct VRegs { u32x4 t[32 / (64 / (HD / 8))]; };
template <int HD> __device__ __forceinline__ void load_v(VRegs<HD>& R, const bf16_t* v, long vstride, int kp0, int nkeys, int lane) {
    constexpr int LPR = HD / 8  , RPI = 64 / LPR  ;
#pragma unroll
    for (int i = 0; i < 32 / RPI; ++i) { const int row = i * RPI + lane / LPR; int kp = kp0 + row; kp = kp < 0 ? 0 : (kp >= nkeys ? nkeys - 1 : kp);
        R.t[i] = *(const u32x4*)(v + (long)kp * vstride + (lane % LPR) * 8); }
}
template <int HD> __device__ __forceinline__ void write_v(const VRegs<HD>& R, WA_LAS unsigned char* vl, int lane) {
    constexpr int VP = HD * 2 + 64, LPR = HD / 8, RPI = 64 / LPR;
#pragma unroll
    for (int i = 0; i < 32 / RPI; ++i) { const int row = i * RPI + lane / LPR; *(WA_LAS u32x4*)(vl + row * VP + (lane % LPR) * 16) = R.t[i]; }
}
template <int HD> __device__ __forceinline__ void stage_v(WA_LAS unsigned char* vl, const bf16_t* v, long vstride, int kp0, int nkeys, int lane) {
    VRegs<HD> R; load_v<HD>(R, v, vstride, kp0, nkeys, lane); write_v<HD>(R, vl, lane);
}
template <int HD> __device__ __forceinline__ void pv_tile(f32x16 (&o)[HD / 32], const f32x16& p, const WA_LAS unsigned char* vl, int lane) {
    constexpr int VP = HD * 2 + 64;
    const int hh = lane >> 5, i16 = lane & 15, q4 = i16 >> 2, p4 = i16 & 3, dsel = (lane >> 4) & 1;
    bf16x8 pb[2];
#pragma unroll
    for (int s2 = 0; s2 < 2; ++s2) { u32x4 w; w.x = cvtpk(p[8 * s2 + 0], p[8 * s2 + 1]); w.y = cvtpk(p[8 * s2 + 2], p[8 * s2 + 3]); w.z = cvtpk(p[8 * s2 + 4], p[8 * s2 + 5]); w.w = cvtpk(p[8 * s2 + 6], p[8 * s2 + 7]);
        pb[s2] = __builtin_bit_cast(bf16x8, w); }
    const WA_LAS unsigned char* base = vl + (4 * hh + q4) * VP + (16 * dsel + 4 * p4) * 2;
#pragma unroll
    for (int dc = 0; dc < HD / 32; ++dc)
#pragma unroll
        for (int s2 = 0; s2 < 2; ++s2) {
            const s16x4 lo = vtr(base + (16 * s2) * VP + dc * 64), hi = vtr(base + (16 * s2 + 8) * VP + dc * 64);
            const bf16x8 a = (bf16x8){lo[0], lo[1], lo[2], lo[3], hi[0], hi[1], hi[2], hi[3]};
            o[dc] = st16::mfma32(a, pb[s2], o[dc]);
        }
}
template <int HD> __device__ __forceinline__ void store_o(const f32x16 (&o)[HD / 32], float scale, bf16_t* orow, int hh) {
#pragma unroll
    for (int dc = 0; dc < HD / 32; ++dc)
#pragma unroll
        for (int g = 0; g < 4; ++g) { u32x2 w; w.x = cvtpk(o[dc][4 * g] * scale, o[dc][4 * g + 1] * scale); w.y = cvtpk(o[dc][4 * g + 2] * scale, o[dc][4 * g + 3] * scale);
            *(u32x2*)(orow + 32 * dc + 8 * g + 4 * hh) = w; }
}

#ifndef WA_OLDS_SM
#define WA_OLDS_SM 1
#endif
#ifndef WA_OLDS_SB
#define WA_OLDS_SB 1
#endif
template <int HD> __device__ __forceinline__ void store_o_lds(const f32x16 (&o)[HD / 32], float scale, bf16_t* obase, long ostride, WA_LAS unsigned char* vl, int lane) {
    constexpr int P = HD * 2 + 16, LPR = HD / 8, RPI = 64 / LPR;
    asm volatile("v_mbcnt_lo_u32_b32 %0, -1, 0\n\tv_mbcnt_hi_u32_b32 %0, -1, %0" : "=v"(lane));
    const int q = lane & 31, hh = lane >> 5;
#pragma unroll
    for (int dc = 0; dc < HD / 32; ++dc)
#pragma unroll
        for (int g = 0; g < 4; ++g) { u32x2 w; w.x = cvtpk(o[dc][4 * g] * scale, o[dc][4 * g + 1] * scale); w.y = cvtpk(o[dc][4 * g + 2] * scale, o[dc][4 * g + 3] * scale);
            *(WA_LAS u32x2*)(vl + q * P + (32 * dc + 8 * g + 4 * hh) * 2) = w; }
#pragma unroll
    for (int j = 0; j < 32 / RPI; ++j) { const int row = j * RPI + lane / LPR;
        const u32x4 w = *(const WA_LAS u32x4*)(vl + row * P + (lane % LPR) * 16);
        *(u32x4*)(obase + (long)row * ostride + (lane % LPR) * 8) = w; }
}

struct SmUnit {
    const bf16_t* q;
    const bf16_t* k;
    const bf16_t* v;
    bf16_t* o;
    long qstride, kstride, vstride, ostride;
    int qpos0, kpos0, nkeys, maxdist, causal;
    float sink;
    float* lse; long lsestride;
    const bf16_t* qt; const bf16_t* kt; int ntiles;
};
template <int HD, int TPC, int NCH, bool SINK, bool LSE, bool TIL, bool ROT = false>
__device__ __forceinline__ void sm_unit(const SmUnit& U, WA_LAS unsigned char* vl, int lane) {
    const int r = lane & 31, hh = lane >> 5;
    bf16x8 qf[HD / 16];
    { const bf16_t* qp = TIL ? U.qt + lane * 8 : U.q + (long)r * U.qstride + 8 * hh;
#pragma unroll
      for (int s = 0; s < HD / 16; ++s) qf[s] = *(const bf16x8*)(qp + (TIL ? 512 : 16) * s); }
    f32x16 o[HD / 32];
#pragma unroll
    for (int dc = 0; dc < HD / 32; ++dc)
#pragma unroll
        for (int i = 0; i < 16; ++i) o[dc][i] = 0.f;
    float m = -1e30f, l = 0.f;
    const int qpos = U.qpos0 + r;
    const int rot = ROT ? (((U.kpos0 >> 5) % TPC) + TPC) % TPC : 0;
#define WA_TT(tau_) ((tau_) - rot < 0 ? (tau_) - rot + TPC : (tau_) - rot)
#pragma unroll 1
    for (int ch = 0; ch < NCH; ++ch) {
        const int kb = U.kpos0 + ch * TPC * 32;
        f32x16 S[TPC];
        constexpr bool VPF = (NCH == 1);
        VRegs<HD> vr; if (VPF) load_v<HD>(vr, U.v, U.vstride, kb + 32 * WA_TT(0), U.nkeys, lane);
        bf16x8 kf[HD / 16];
#define WA_KLOAD(dst, t_) do { int kp_ = kb + 32 * WA_TT(t_) + r; kp_ = kp_ < 0 ? 0 : (kp_ >= U.nkeys ? U.nkeys - 1 : kp_); int ti_ = (kb >> 5) + WA_TT(t_); ti_ = ti_ < 0 ? 0 : (ti_ >= U.ntiles ? U.ntiles - 1 : ti_); \
            const bf16_t* kptr_ = TIL ? U.kt + (long)ti_ * (HD / 16) * 512 + lane * 8 : U.k + (long)kp_ * U.kstride + 8 * hh; \
            _Pragma("unroll") for (int s = 0; s < HD / 16; ++s) dst[s] = *(const bf16x8*)(kptr_ + (TIL ? 512 : 16) * s); } while (0)
        WA_KLOAD(kf, 0);
#pragma unroll
        for (int t = 0; t < TPC; ++t) {
            bf16x8 kn[HD / 16];
            if (t + 1 < TPC) WA_KLOAD(kn, t + 1);
            asm volatile("" ::: "memory");
#pragma unroll
            for (int i = 0; i < 16; ++i) S[t][i] = 0.f;
#pragma unroll
            for (int s = 0; s < HD / 16; ++s) S[t] = st16::mfma32(kf[s], qf[s], S[t]);
            if (t + 1 < TPC) {
#pragma unroll
                for (int s = 0; s < HD / 16; ++s) kf[s] = kn[s]; }
        }
#undef WA_KLOAD
        float cm = -1e30f;
#pragma unroll
        for (int t = 0; t < TPC; ++t) {
            const int p0 = kb + 32 * WA_TT(t), p1 = p0 + 31;
            const bool allv = WA_MASK_SKIP && (p0 >= 0) && (p1 < U.nkeys) && (!U.causal || p1 <= U.qpos0) && (U.qpos0 + 31 - p0 <= U.maxdist);
            if (allv) {
#pragma unroll
                for (int i = 0; i < 16; ++i) cm = fmaxf(cm, S[t][i]);
            } else {
#pragma unroll
                for (int i = 0; i < 16; ++i) { const int kp = p0 + kofs(i, hh);
                    const bool ok = (kp >= 0) && (kp < U.nkeys) && (!U.causal || kp <= qpos) && (qpos - kp <= U.maxdist);
                    const float sv = ok ? S[t][i] : -INFINITY; S[t][i] = sv; cm = fmaxf(cm, sv); }
            }
        }
        cm = fmaxf(cm, __shfl_xor(cm, 32));
        if (SINK && ch == 0) cm = fmaxf(cm, U.sink);
        const float mn = fmaxf(m, cm), alpha = __builtin_amdgcn_exp2f(m - mn);
        float ps = 0.f;
#pragma unroll
        for (int t = 0; t < TPC; ++t)
#pragma unroll
            for (int i = 0; i < 16; ++i) { const float p = __builtin_amdgcn_exp2f(S[t][i] - mn); S[t][i] = p; ps += p; }
        ps += __shfl_xor(ps, 32);
        if (SINK && ch == 0) ps += __builtin_amdgcn_exp2f(U.sink - mn);
        l = l * alpha + ps; m = mn;
        if (NCH > 1) {
#pragma unroll
            for (int dc = 0; dc < HD / 32; ++dc)
#pragma unroll
                for (int i = 0; i < 16; ++i) o[dc][i] *= alpha; }
        { if (!VPF) load_v<HD>(vr, U.v, U.vstride, kb + 32 * WA_TT(0), U.nkeys, lane);
          asm volatile("" : "+v"(S[0][0]) :: "memory");
#pragma unroll
          for (int t = 0; t < TPC; ++t) {
              VRegs<HD> vn; if (VPF && t + 1 < TPC) load_v<HD>(vn, U.v, U.vstride, kb + 32 * WA_TT(t + 1), U.nkeys, lane);
              write_v<HD>(vr, vl, lane); pv_tile<HD>(o, S[t], vl, lane);
              if (t + 1 < TPC) { if (VPF) vr = vn; else load_v<HD>(vr, U.v, U.vstride, kb + 32 * WA_TT(t + 1), U.nkeys, lane); } } }
    }
#undef WA_TT
    const float inv = 1.0f / l;
    if (WA_OLDS_SM) store_o_lds<HD>(o, inv, U.o, U.ostride, vl, lane); else store_o<HD>(o, inv, U.o + (long)r * U.ostride, hh);
    if (LSE) { if (hh == 0) U.lse[(long)r * U.lsestride] = (m + __builtin_amdgcn_logf(l)) * LN2; }
}

#ifndef SB_EARLY_EXIT
#define SB_EARLY_EXIT 1
#endif
constexpr float SB_EXIT_T = 110.0f;
template <int HD>
__device__ __forceinline__ void sb_unit(const bf16_t* qT, const bf16_t* kT, const bf16_t* v, bf16_t* o, long stride, int qpos0, WA_LAS unsigned char* vl, int lane) {
    const int r = lane & 31, hh = lane >> 5;
    bf16x8 qf[HD / 16];
    { const bf16_t* qp = qT + (long)(qpos0 >> 5) * (HD / 16) * 512 + lane * 8;
#pragma unroll
      for (int s = 0; s < HD / 16; ++s) qf[s] = *(const bf16x8*)(qp + 512 * s); }
    f32x16 oacc[HD / 32];
#pragma unroll
    for (int dc = 0; dc < HD / 32; ++dc)
#pragma unroll
        for (int i = 0; i < 16; ++i) oacc[dc][i] = 0.f;
    float carry = 1.f;
    const int qpos = qpos0 + r, ktd = qpos0 >> 5;
    bf16x8 kf[HD / 16];
    { const bf16_t* kptr = kT + (long)ktd * (HD / 16) * 512 + lane * 8;
#pragma unroll
      for (int s = 0; s < HD / 16; ++s) kf[s] = *(const bf16x8*)(kptr + 512 * s); }
    for (int kt = ktd; kt >= 0; --kt) {
        const int kn = kt > 0 ? kt - 1 : 0;
        VRegs<HD> vr; load_v<HD>(vr, v, stride, 32 * kt, 1 << 30, lane);
        bf16x8 kfn[HD / 16];
        { const bf16_t* kptr = kT + (long)kn * (HD / 16) * 512 + lane * 8;
#pragma unroll
          for (int s = 0; s < HD / 16; ++s) kfn[s] = *(const bf16x8*)(kptr + 512 * s); }
        asm volatile("" ::: "memory");
        f32x16 S;
#pragma unroll
        for (int i = 0; i < 16; ++i) S[i] = 0.f;
#pragma unroll
        for (int s = 0; s < HD / 16; ++s) S = st16::mfma32(kf[s], qf[s], S);
        const bool diag = (kt == ktd);
        float kp[16];
        f32x16 A;
#pragma unroll
        for (int i = 0; i < 16; ++i) { const float z = S[i]; const bool ok = !diag || (32 * kt + kofs(i, hh) < qpos);
            const float ez = __builtin_amdgcn_exp2f(-fabsf(z) * LOG2E), rc = __builtin_amdgcn_rcpf(1.0f + ez), er = ez * rc;
            const float sg = z >= 0.f ? rc : er, kk = z >= 0.f ? er : rc;
            A[i] = ok ? sg : 0.f; kp[i] = ok ? kk : 1.f; }
        float gs[4], pg[4];
#pragma unroll
        for (int g = 0; g < 4; ++g) { gs[g] = (kp[4 * g] * kp[4 * g + 1]) * (kp[4 * g + 2] * kp[4 * g + 3]); pg[g] = __shfl_xor(gs[g], 32); }
        float run = carry;
#pragma unroll
        for (int g = 3; g >= 0; --g) { const float T = run * (hh == 0 ? pg[g] : 1.f);
            const float t3 = T, t2 = t3 * kp[4 * g + 3], t1 = t2 * kp[4 * g + 2], t0 = t1 * kp[4 * g + 1];
            A[4 * g + 3] *= t3; A[4 * g + 2] *= t2; A[4 * g + 1] *= t1; A[4 * g] *= t0;
            run *= gs[g] * pg[g]; }
        carry = run;
        asm volatile("" : "+v"(A[0]), "+v"(A[15]) :: "memory");
        write_v<HD>(vr, vl, lane);
        pv_tile<HD>(oacc, A, vl, lane);
#if SB_EARLY_EXIT
        if (__all(carry == 0.f)) break;
#endif
#pragma unroll
        for (int s = 0; s < HD / 16; ++s) kf[s] = kfn[s];
    }
    if (WA_OLDS_SB) store_o_lds<HD>(oacc, 1.0f, o, stride, vl, lane); else store_o<HD>(oacc, 1.0f, o + (long)r * stride, hh);
}
}

constexpr int NWAVES = 8;
constexpr int BATCH = 4, SEQ = 4096, DM = 2048, DEPTH = 4, NMEM = 256, FF = 5632;
constexpr int MT = BATCH * SEQ;
constexpr int MMEM = BATCH * NMEM;
constexpr size_t MiB = 1u << 20;
constexpr size_t WS_CTL = 0;
constexpr size_t WS_SS = 1 * MiB;
constexpr size_t SS_BYTES = (size_t)MT * 8;
constexpr size_t ZERO_BYTES = 3328 * 1024;
constexpr size_t WS_W = 4 * MiB;
constexpr size_t WL_STRIDE = 168 * MiB, WL_GU1 = 0, WL_DN1 = 44 * MiB, WL_GU2 = 66 * MiB, WL_DN2 = 110 * MiB, WL_MQKV = 132 * MiB, WL_MO = 156 * MiB, WL_XQ = 164 * MiB, WL_XO = 166 * MiB;
constexpr size_t WS_WKV = WS_W + 4 * WL_STRIDE;
constexpr size_t WS_XB = WS_WKV + 16 * MiB;
constexpr size_t WS_MEMB = WS_XB + 64 * MiB;
constexpr size_t WS_ACT = WS_MEMB + 4 * MiB;
constexpr size_t WS_QKV = WS_ACT + 176 * MiB;
constexpr size_t WS_O = WS_QKV + 192 * MiB;
constexpr size_t WS_XQ = WS_O + 64 * MiB;
constexpr size_t WS_XO = WS_XQ + 16 * MiB;
constexpr size_t WS_KVM = WS_XO + 16 * MiB;
constexpr size_t WS_LSE = WS_KVM + 8 * MiB;
constexpr size_t WS_TABD = WS_LSE + 1 * MiB;
constexpr size_t WS_TABS = WS_TABD + 2 * MiB;
constexpr size_t WS_SSMEM = WS_TABS + 1 * MiB;
constexpr size_t WS_END = WS_SSMEM + 1 * MiB;
static_assert(WS_SS + 17 * SS_BYTES <= ZERO_BYTES && ZERO_BYTES <= WS_W, "zeroed region");
static_assert(WS_END < 1400ull * MiB, "workspace map must fit 4x the largest input tensor");
constexpr int CW_BAR = 4096;
constexpr int RING_OFF = 0, RING_BYTES = 131072;
constexpr int LDSCTL_OFF = 135168, MISC_OFF = LDSCTL_OFF + 320;
constexpr int LDS_BYTES = 147456;

#define GAS __attribute__((address_space(1)))
#define LAS __attribute__((address_space(3)))
typedef unsigned short bf16;
typedef unsigned v4u __attribute__((ext_vector_type(4)));
typedef unsigned v2u __attribute__((ext_vector_type(2)));
typedef float f32x4 __attribute__((ext_vector_type(4)));
#define LDS_WAIT() asm volatile("s_waitcnt lgkmcnt(0)" ::: "memory")
#define VM_WAIT() asm volatile("s_waitcnt vmcnt(0)" ::: "memory")
__device__ __forceinline__ unsigned pk2(float lo, float hi) { return pg8::cvt_pk_bf16(lo, hi); }
__device__ __forceinline__ float wave_sum(float v) {
#pragma unroll
    for (int o = 1; o < 64; o <<= 1) v += __shfl_xor(v, o);
    return v;
}
__device__ const float INVF_D[16] = {1.000000000e+00f, 4.403665960e-01f, 1.939227432e-01f, 8.539710194e-02f, 3.760603070e-02f, 1.656043902e-02f, 7.292664610e-03f, 3.211445874e-03f,
                                     1.414213562e-03f, 6.227723788e-04f, 2.742481884e-04f, 1.207697351e-04f, 5.318296098e-05f, 2.341999971e-05f, 1.031338616e-05f, 4.541670478e-06f};
__device__ const float INVF_S[8] = {1.000000000e+00f, 1.939227432e-01f, 3.760603070e-02f, 7.292664610e-03f, 1.414213562e-03f, 2.742481884e-04f, 5.318296098e-05f, 1.031338616e-05f};

#define XB_TMO      128
#define XB_XCNT(j)  (256  + 64 * (j))
#define XB_XSUB(j)  (1280 + 64 * (j))
#define XB_XGEN(j)  (2304 + 64 * (j))
#define XB_TOP      3328
#define XB_TOPGEN   3392
#define XCD_BAR_WORDS 3456
#define XB_SPIN_CAP (1u << 18)
#ifndef XB_FLAT_RELEASE
#define XB_FLAT_RELEASE 1
#endif

__device__ __forceinline__ unsigned xb_ld(unsigned* p)              { return __hip_atomic_load(p, __ATOMIC_RELAXED, __HIP_MEMORY_SCOPE_AGENT); }
__device__ __forceinline__ unsigned xb_add(unsigned* p, unsigned v) { return __hip_atomic_fetch_add(p, v, __ATOMIC_RELAXED, __HIP_MEMORY_SCOPE_AGENT); }
__device__ __forceinline__ unsigned xb_xcc_id() { return (unsigned)__builtin_amdgcn_s_getreg((3 << 11) | 20) & 0xFu; }
#define XB_SPIN(cond, bar) do { unsigned _sp = 0; while (cond) { __builtin_amdgcn_s_sleep(1); \
    if ((++_sp & 255u) == 0u) { if (xb_ld(&(bar)[XB_TMO])) break; if (_sp > XB_SPIN_CAP) { atomicAdd(&(bar)[XB_TMO], 1u); break; } } } } while (0)

struct XcdBarrier {
    unsigned* bar; unsigned x; unsigned ng;
    volatile LAS unsigned* st;
};

__device__ __forceinline__ XcdBarrier xcd_barrier_post(unsigned* bar, volatile LAS unsigned* st, const bool t0  ) {
    XcdBarrier b; b.bar = bar; b.x = xb_xcc_id(); b.st = st; b.ng = 0u;
    if (t0) (void)xb_add(&bar[XB_XCNT(b.x)], 1u);
    return b;
}
__device__ __forceinline__ void xcd_barrier_complete(unsigned* bar, unsigned x, unsigned& nloc, unsigned& nx, const unsigned G) {
    unsigned sum, cnt, mine, sp = 0u;
    for (;;) {
        sum = 0u; cnt = 0u; mine = 0u;
#pragma unroll
        for (unsigned j = 0; j < 16; ++j) { const unsigned c = xb_ld(&bar[XB_XCNT(j)]); sum += c; cnt += (c > 0u) ? 1u : 0u; mine = (j == x) ? c : mine; }
        if (sum == G) break;
        __builtin_amdgcn_s_sleep(1);
        if ((++sp & 255u) == 0u) { if (xb_ld(&bar[XB_TMO])) break; if (sp > XB_SPIN_CAP) { atomicAdd(&bar[XB_TMO], 1u); break; } }
    }
    nloc = mine > 0u ? mine : 1u; nx = cnt > 0u ? cnt : 1u;
}

__device__ __forceinline__ void xcd_barrier(const XcdBarrier& b, const bool t0) {
    asm volatile("s_waitcnt vmcnt(0)" ::: "memory");
    __syncthreads();
    if (t0) {
        unsigned* bar = b.bar;
        __builtin_amdgcn_s_waitcnt(0);
        unsigned nloc = b.st[0], nx = b.st[1];
        if (nloc == 0u) { xcd_barrier_complete(bar, b.x, nloc, nx, b.ng); b.st[0] = nloc; b.st[1] = nx; }
        const unsigned old = xb_add(&bar[XB_XSUB(b.x)], 1u);
        const unsigned gen = old / nloc;
        if (old + 1u == (gen + 1u) * nloc) {
            __builtin_amdgcn_fence(__ATOMIC_RELEASE, "agent");
            asm volatile("s_waitcnt vmcnt(0)" ::: "memory");
            const unsigned og = xb_add(&bar[XB_TOP], 1u);
            const unsigned tg = og / nx;
            if (og + 1u == (tg + 1u) * nx) xb_add(&bar[XB_TOPGEN], 1u);
            else XB_SPIN(xb_ld(&bar[XB_TOPGEN]) == tg, bar);
            __builtin_amdgcn_fence(__ATOMIC_ACQUIRE, "agent");
            if (!XB_FLAT_RELEASE) xb_add(&bar[XB_XGEN(b.x)], 1u);
            asm volatile("s_waitcnt vmcnt(0)" ::: "memory");
        } else {
            if (XB_FLAT_RELEASE) XB_SPIN(xb_ld(&bar[XB_TOPGEN]) == gen, bar);
            else XB_SPIN(xb_ld(&bar[XB_XGEN(b.x)]) == gen, bar);
            __builtin_amdgcn_fence(__ATOMIC_ACQUIRE, "agent");
            asm volatile("s_waitcnt vmcnt(0)" ::: "memory");
        }
    }
    __syncthreads();
}

__device__ __forceinline__ void conv_items(int& it, const int NGW, const float* W, const int K, const int N, const float* gain, const float scale, bf16* WT, const int mode, const int lane) {
    const int nblk = N >> 6, nitems = (K >> 6) * nblk, g = lane >> 4, j = lane & 15;
    while (it < nitems) {
        const int kb = it / nblk, nb = it - kb * nblk, k0 = kb << 6, n0 = nb << 6;
        const float* src = W + (size_t)(k0 + 16 * g) * N + n0 + 4 * j;
        f32x4 t[16];
#pragma unroll
        for (int i = 0; i < 16; ++i) t[i] = *(const f32x4*)(src + (size_t)i * N);
        f32x4 gv[4];
#pragma unroll
        for (int q = 0; q < 4; ++q) gv[q] = gain ? *(const f32x4*)(gain + k0 + 16 * g + 4 * q) * scale : (f32x4){scale, scale, scale, scale};
        int drow0 = n0; if (mode == 1) { const int hf = n0 >= FF ? 1 : 0; const int j0 = n0 - hf * FF; drow0 = (j0 >> 7) * 256 + hf * 128 + (j0 & 127); }
        if (mode >= 16) drow0 = (n0 < 512 ? 0 : 2048 - 512) + (mode - 16) * 512 + n0;
#pragma unroll
        for (int c = 0; c < 4; ++c) {
            v4u o0, o1;
            o0.x = pk2(t[0][c] * gv[0][0], t[1][c] * gv[0][1]); o0.y = pk2(t[2][c] * gv[0][2], t[3][c] * gv[0][3]); o0.z = pk2(t[4][c] * gv[1][0], t[5][c] * gv[1][1]); o0.w = pk2(t[6][c] * gv[1][2], t[7][c] * gv[1][3]);
            o1.x = pk2(t[8][c] * gv[2][0], t[9][c] * gv[2][1]); o1.y = pk2(t[10][c] * gv[2][2], t[11][c] * gv[2][3]); o1.z = pk2(t[12][c] * gv[3][0], t[13][c] * gv[3][1]); o1.w = pk2(t[14][c] * gv[3][2], t[15][c] * gv[3][3]);
            bf16* dst = WT + (size_t)(drow0 + 4 * j + c) * K + k0 + 16 * g;
            *(v4u*)dst = o0; *(v4u*)(dst + 8) = o1;
        }
        it += NGW;
    }
    it -= nitems;
}
__device__ __forceinline__ void row_to_bf16_ss(const float* xrow, bf16* orow, pg8::ssq_t* ssp, const int lane) {
    const f32x4* xr = (const f32x4*)xrow + lane; f32x4 v[8]; float s = 0.f;
#pragma unroll
    for (int j = 0; j < 8; ++j) { v[j] = xr[64 * j]; s += (v[j].x * v[j].x + v[j].y * v[j].y) + (v[j].z * v[j].z + v[j].w * v[j].w); }
    s = wave_sum(s);
    v2u* o8 = (v2u*)orow + lane;
#pragma unroll
    for (int j = 0; j < 8; ++j) { v2u w; w.x = pk2(v[j].x, v[j].y); w.y = pk2(v[j].z, v[j].w); o8[64 * j] = w; }
    if (lane == 0) *ssp = pg8::ssq_fix(s);
}

struct Args { const float* in[25]; float* out; unsigned char* ws; int lo, hi; };
constexpr int NPHASES = 43;
#ifndef MK_NG
#define MK_NG 1
#endif
constexpr int NG = MK_NG;

#ifndef MK_ONE_LAUNCH
#define MK_ONE_LAUNCH 1
#endif
#ifndef ATT_REP
#define ATT_REP 1
#endif
#ifndef DIL_XD
#define DIL_XD 1
#endif
#ifndef DIL_ROT
#define DIL_ROT 1
#endif
#ifndef BAR_REP
#define BAR_REP 1
#endif
#ifndef XA_TPC
#define XA_TPC 2
#endif
#ifndef SWA_TIL
#define SWA_TIL 1
#endif
#ifndef SWA_XD
#define SWA_XD 1
#endif
#ifndef PROBE_SAMEKV
#define PROBE_SAMEKV 0
#endif
#ifndef ATT_REP_KIND
#define ATT_REP_KIND -1
#endif
__global__ void __launch_bounds__(NWAVES * 64, 2) mk_fwd(Args args) {
    extern __shared__ __attribute__((aligned(16))) unsigned char lds_raw[];
    LAS unsigned char* lds = (LAS unsigned char*)lds_raw;
    volatile LAS unsigned* MISC = (volatile LAS unsigned*)(lds + MISC_OFF);
    const int wave = __builtin_amdgcn_readfirstlane((int)threadIdx.x >> 6);
#define LANE_ID(v) int v; asm volatile("v_mbcnt_lo_u32_b32 %0, -1, 0\n\tv_mbcnt_hi_u32_b32 %0, -1, %0" : "=v"(v))
    const int G = gridDim.x, bx = blockIdx.x;
    const int vcu = (G % 8 == 0) ? (bx % 8) * (G / 8) + bx / 8 : bx;
    const int gw = vcu * NWAVES + wave, NGW = G * NWAVES;
    const bool grp_ok = (G % (8 * NG) == 0) || NG == 1;
    const int ngr = grp_ok ? NG : 1, XPG = 8 / ngr;
    const int gidx = ngr == 1 ? 0 : (bx % 8) / XPG, lb = ngr == 1 ? bx : (bx / 8) * XPG + (bx % 8) % XPG, GL = G / ngr, nxl = ngr == 1 ? 8 : XPG;
    const int BG = BATCH / ngr, MG = MT / ngr, r0 = gidx * MG, MMG = MMEM / ngr, mr0 = gidx * MMG;
    const int lwv = lb * NWAVES + wave, NLW = GL * NWAVES;
    unsigned char* const ws = args.ws;
    { LANE_ID(l0); const int tid = wave * 64 + l0;
      for (int u = tid; u < (LDS_BYTES - LDSCTL_OFF) / 4; u += NWAVES * 64) ((LAS unsigned*)(lds + LDSCTL_OFF))[u] = 0u;
      __syncthreads();
      (void)xcd_barrier_post((unsigned*)(ws + WS_CTL) + CW_BAR + gidx * XCD_BAR_WORDS, MISC + 8, tid == 0);
      (void)xcd_barrier_post((unsigned*)(ws + WS_CTL) + CW_BAR + NG * XCD_BAR_WORDS, MISC + 12, tid == 0); }
    const int lo = args.lo, hi = args.hi;
    int ph = 0;
#define PH_IF if (ph >= lo && ph < hi)
#define PH_END do { if (ph >= lo && ph + 1 < hi) { XcdBarrier bar_; const bool glob_ = (ph == 0); \
        bar_.bar = (unsigned*)(ws + WS_CTL) + CW_BAR + (glob_ ? NG : gidx) * XCD_BAR_WORDS; bar_.x = xb_xcc_id(); bar_.st = MISC + (glob_ ? 12 : 8); bar_.ng = (unsigned)(glob_ ? G : GL); \
        LANE_ID(lb_); for (int br_ = 0; br_ < BAR_REP; ++br_) xcd_barrier(bar_, wave == 0 && lb_ == 0); } ++ph; } while (0)

#define xout (args.out)
#define xb ((bf16*)(ws + WS_XB))
#define memb ((bf16*)(ws + WS_MEMB))
#define act ((bf16*)(ws + WS_ACT))
#define qbuf ((bf16*)(ws + WS_QKV))
#define kbuf ((bf16*)(ws + WS_QKV + 64 * MiB))
#define vbuf ((bf16*)(ws + WS_QKV + 128 * MiB))
#define obuf ((bf16*)(ws + WS_O))
#define xqbuf ((bf16*)(ws + WS_XQ))
#define xobuf ((bf16*)(ws + WS_XO))
#define kvm ((bf16*)(ws + WS_KVM))
#define ssb ((pg8::ssq_t*)(ws + WS_SS))
#define ssmem ((pg8::ssq_t*)(ws + WS_SSMEM))
#define lseb ((float*)(ws + WS_LSE))
#define tabD ((float*)(ws + WS_TABD))
#define tabS ((float*)(ws + WS_TABS))
#define vl (lds + RING_OFF + wave * 10240)

    PH_IF {
        LANE_ID(lane); const int tid = wave * 64 + lane;
        int it = gw;
        for (int L = 0; L < DEPTH; ++L) {
            unsigned char* wl = ws + WS_W + (size_t)L * WL_STRIDE; const int kind = L % 3, j = L / 3;
            conv_items(it, NGW, args.in[4] + (size_t)L * DM * 2 * FF, DM, 2 * FF, args.in[3] + L * DM, 1.0f, (bf16*)(wl + WL_GU1), 1, lane);
            conv_items(it, NGW, args.in[5] + (size_t)L * FF * DM, FF, DM, nullptr, 0.5f, (bf16*)(wl + WL_DN1), 0, lane);
            conv_items(it, NGW, args.in[22] + (size_t)L * DM * 2 * FF, DM, 2 * FF, args.in[21] + L * DM, 1.0f, (bf16*)(wl + WL_GU2), 1, lane);
            conv_items(it, NGW, args.in[23] + (size_t)L * FF * DM, FF, DM, nullptr, 0.5f, (bf16*)(wl + WL_DN2), 0, lane);
            if (kind == 0) {
                conv_items(it, NGW, args.in[7] + (size_t)j * DM * 6144, DM, 6144, args.in[6] + L * DM, 1.0f, (bf16*)(wl + WL_MQKV), 0, lane);
                conv_items(it, NGW, args.in[8] + (size_t)j * 2048 * DM, 2048, DM, nullptr, 1.0f, (bf16*)(wl + WL_MO), 0, lane);
            } else if (kind == 1) {
                conv_items(it, NGW, args.in[9] + (size_t)j * DM * 4608, DM, 4608, args.in[6] + L * DM, 1.0f, (bf16*)(wl + WL_MQKV), 0, lane);
                conv_items(it, NGW, args.in[10] + (size_t)j * 1536 * DM, 1536, DM, nullptr, 1.0f, (bf16*)(wl + WL_MO), 0, lane);
            } else {
                conv_items(it, NGW, args.in[11] + (size_t)j * DM * 2560, DM, 2560, args.in[6] + L * DM, 1.0f, (bf16*)(wl + WL_MQKV), 0, lane);
                conv_items(it, NGW, args.in[14] + (size_t)j * 2048 * DM, 2048, DM, nullptr, 1.0f, (bf16*)(wl + WL_MO), 0, lane);
            }
            conv_items(it, NGW, args.in[18] + (size_t)L * DM * 512, DM, 512, args.in[16] + L * DM, 1.0f, (bf16*)(wl + WL_XQ), 0, lane);
            conv_items(it, NGW, args.in[19] + (size_t)L * DM * 1024, DM, 1024, args.in[17] + L * DM, 1.0f, (bf16*)(ws + WS_WKV), 16 + L, lane);
            conv_items(it, NGW, args.in[20] + (size_t)L * 512 * DM, 512, DM, nullptr, 1.0f, (bf16*)(wl + WL_XO), 0, lane);
        }
        for (int m = gw; m < MT; m += NGW) row_to_bf16_ss(args.in[0] + (size_t)m * DM, xb + (size_t)m * DM, ssb + m, lane);
        for (int m = gw; m < MMEM; m += NGW) row_to_bf16_ss(args.in[1] + (size_t)m * DM, memb + (size_t)m * DM, ssmem + m, lane);
        const int* pos = (const int*)args.in[2];
        for (int i = bx * (NWAVES * 64) + tid; i < MT * 16; i += G * NWAVES * 64) { const int t = i >> 4, f = i & 15; const float ang = (float)pos[t] * INVF_D[f];
            const double rev = (double)ang * 0.15915494309189535; const float fr = (float)(rev - floor(rev));
            tabD[2 * i] = __builtin_amdgcn_cosf(fr); tabD[2 * i + 1] = __builtin_amdgcn_sinf(fr); }
        for (int i = bx * (NWAVES * 64) + tid; i < MT * 8; i += G * NWAVES * 64) { const int t = i >> 3, f = i & 7; const float ang = (float)pos[t] * INVF_S[f];
            const double rev = (double)ang * 0.15915494309189535; const float fr = (float)(rev - floor(rev));
            tabS[2 * i] = __builtin_amdgcn_cosf(fr); tabS[2 * i + 1] = __builtin_amdgcn_sinf(fr); }
    }
    PH_END;


    for (int s = 0; s < 2 * DEPTH; ++s) {
        const int L = s >> 1, f = s & 1;
        unsigned char* const wl = ws + WS_W + (size_t)L * WL_STRIDE;
        PH_IF {
            pg8::Gemm g{xb + (size_t)r0 * DM, (const bf16*)(wl + (f ? WL_GU2 : WL_GU1)), MG, 2 * FF, DM}; pg8::GroupOrder S; S.init(MG, 2 * FF, GL, lb, nxl);
            pg8::EpiSwiGLU E{act, FF, ssb + (size_t)(4 * L + (f ? 3 : 0)) * MT, r0};
            pg8::gemm_phase<pg8::EpiSwiGLU, pg8::GroupOrder, true, true>(lds + RING_OFF, g, S, E, wave);
        }
        PH_END;
        PH_IF {
            pg8::Gemm g{act + (size_t)r0 * FF, (const bf16*)(wl + (f ? WL_DN2 : WL_DN1)), MG, DM, FF}; pg8::GroupOrder S; S.init(MG, DM, GL, lb, nxl, 4);
            pg8::EpiResid E{xb, ssb + (size_t)(4 * L + (f ? 4 : 1)) * MT, nullptr, r0};
            pg8::gemm_phase<pg8::EpiResid, pg8::GroupOrder, true, true>(lds + RING_OFF, g, S, E, wave);
        }
        PH_END;
        if (f) continue;
        const int kind = L % 3, jm = L / 3;
        PH_IF {
            const int N = kind == 0 ? 6144 : (kind == 1 ? 4608 : 2560);
            pg8::Gemm g{xb + (size_t)r0 * DM, (const bf16*)(wl + WL_MQKV), MG, N, DM}; pg8::GroupOrder S; S.init(MG, N, GL, lb, nxl);
            const pg8::EpiProj E{qbuf, (size_t)(32 * MiB), kind == 1 ? 1536 : 2048, kind == 0 ? 2048 : (kind == 1 ? 1536 : 256), kind == 1 ? 6 : 8, kind == 0 ? 16 : (kind == 1 ? 12 : 9),
                                 ssb + (size_t)(4 * L + 1) * MT, kind == 2 ? args.in[12] + jm * 2560 : nullptr,
                                 kind == 0 ? 0.08838834764831845f : (kind == 1 ? 0.08838834764831845f * 1.4426950408889634f : 0.125f * 1.4426950408889634f),
                                 kind == 0 ? 0 : (kind == 1 ? 128 : 64), kind == 1 ? (const float*)tabD : (const float*)tabS, r0, kind == 0 ? (3 | (4 << 4)) : (kind == 1 ? (3 | (4 << 4) | 256) : (SWA_TIL ? (3 | (4 << 4) | 512) : 0))};
            pg8::gemm_phase<pg8::EpiProj, pg8::GroupOrder, true, true>(lds + RING_OFF, g, S, E, wave);
        }
        PH_END;
        PH_IF for (int rep_ = 0; rep_ < ((ATT_REP_KIND < 0 || ATT_REP_KIND == kind) ? ATT_REP : 1); ++rep_) {
            LANE_ID(lane);
            if (kind == 0) {
                const bool xdeal = (NLW == 256 * nxl) && ((BG * 16) % (2 * nxl) == 0) && (BG * 2048 == 4 * NLW);
                for (int u = lwv; u < BG * 2048; u += NLW) {
                    const int jj = (u / NLW) & 3, wxl = ((lb / nxl) * NWAVES + wave) & 255;
                    const int c = xdeal ? (wxl & 127) : (u & 127), bhl = xdeal ? (lb % nxl) * (BG * 16 / nxl) + 2 * jj + (wxl >> 7) : (u >> 7), a = c & 31, quarter = ((c >> 5) + jj) & 3;
                    const int qb = quarter == 0 ? a : (quarter == 1 ? 63 - a : (quarter == 2 ? 64 + a : 127 - a));
                    const int b = gidx * BG + (bhl >> 4), h = bhl & 15; const size_t base = (size_t)b * SEQ * 2048 + h * 128;
#ifndef MK_NO_SB
                    wa::sb_unit<128>(qbuf + (size_t)(b * 16 + h) * 524288, kbuf + (size_t)(PROBE_SAMEKV && rep_ + 1 < ATT_REP ? 0 : b * 16 + h) * 524288, vbuf + (PROBE_SAMEKV && rep_ + 1 < ATT_REP ? 0 : base), obuf + base + (size_t)(32 * qb) * 2048, 2048, 32 * qb, vl, lane);
#endif
                }
            } else if (kind == 1) {
                const int wpxd = GL / nxl; const bool xd1 = DIL_XD && (GL % nxl == 0) && (wpxd % 16 == 0) && ((BG * 12) % (nxl * (wpxd / 16)) == 0) && (NWAVES == 8);
                for (int u = lwv, kx = 0; u < BG * 1536; u += NLW, ++kx) {
                    const int ppr = wpxd / 16  , jx = lb / nxl;
                    const int idx = xd1 ? (jx & 15) * 8 + wave : (u & 127), hb = xd1 ? ((lb % nxl) * (BG * 12 / nxl) + kx * ppr + (jx >> 4)) : (u >> 7), head = hb % 12, b = gidx * BG + hb / 12, g2 = 2 * (head >> 2), dil = 1 << g2;
                    const int p = idx >> (7 - g2), qb = idx & ((128 >> g2) - 1);
                    const size_t row0 = (size_t)b * SEQ + p; const size_t qrow = row0 + (size_t)(32 * qb) * dil;
                    wa::SmUnit U; U.q = qbuf + qrow * 1536 + head * 128; U.k = kbuf + row0 * 1536 + head * 128; U.v = vbuf + row0 * 1536 + head * 128; U.o = obuf + qrow * 1536 + head * 128;
                    U.qstride = U.kstride = U.vstride = U.ostride = (long)dil * 1536; U.qpos0 = 32 * qb; U.kpos0 = 32 * qb - 128; U.nkeys = SEQ >> g2; U.maxdist = 128; U.causal = 1; U.sink = 0.f;
                    U.lse = lseb + qrow * 12 + head; U.lsestride = (long)dil * 12;
                    U.ntiles = 128 >> g2; U.kt = kbuf + ((size_t)(b * 12 + head) * 128 + (size_t)p * (128 >> g2)) * 4096; U.qt = qbuf + ((size_t)(b * 12 + head) * 128 + (size_t)p * (128 >> g2) + qb) * 4096;
#ifndef MK_NO_DIL
                    wa::sm_unit<128, 5, 1, false, true, true, DIL_ROT != 0>(U, vl, lane);
#endif
                }
            } else {
                const float* sinks = args.in[13] + jm * 32;
                const int wpx = GL / nxl; const bool xd2 = SWA_XD && (GL % nxl == 0) && (128 % wpx == 0) && ((BG * 4) % nxl == 0) && (NWAVES == 8);
                for (int u = lwv, kx = 0; u < BG * 4096; u += NLW, ++kx) {
                    const int ppp = 128 / wpx, pr = (lb % nxl) * (BG * 4 / nxl) + kx / ppp;
                    const int hq = u & 7, qb = xd2 ? (kx % ppp) * wpx + lb / nxl : (u >> 3) & 127, kvh = xd2 ? (pr & 3) : (u >> 10) & 3, b = gidx * BG + (xd2 ? (pr >> 2) : (u >> 12)), head = kvh * 8 + hq;
                    const size_t row0 = (size_t)b * SEQ, qrow = row0 + 32 * qb;
                    wa::SmUnit U; U.q = qbuf + qrow * 2048 + head * 64; U.k = kbuf + row0 * 256 + kvh * 64; U.v = vbuf + row0 * 256 + kvh * 64; U.o = obuf + qrow * 2048 + head * 64;
                    U.qstride = 2048; U.kstride = 256; U.vstride = 256; U.ostride = 2048; U.qpos0 = 32 * qb; U.kpos0 = 32 * qb - 128; U.nkeys = SEQ; U.maxdist = 127; U.causal = 1;
                    U.sink = sinks[head] * 1.4426950408889634f; U.lse = nullptr; U.lsestride = 0; U.qt = qbuf + ((size_t)(b * 32 + head) * 128 + qb) * 2048; U.kt = kbuf + (size_t)(b * 4 + kvh) * 128 * 2048; U.ntiles = 128;
#ifndef MK_NO_SWA
                    wa::sm_unit<64, 5, 1, true, false, SWA_TIL != 0>(U, vl, lane);
#endif
                }
            }
        }
        PH_END;
        if (kind == 1) {
            PH_IF {
                LANE_ID(lane); const int tid = wave * 64 + lane;
                for (int il = lb * (NWAVES * 64) + tid; il < MG * 192; il += GL * NWAVES * 64) { const int i = r0 * 192 + il; const int row = i / 192, c8 = i - row * 192, head = c8 >> 4, g = head >> 2, jj = head & 3;
                    const float l0 = lseb[row * 12 + jj], l1 = lseb[row * 12 + 4 + jj], l2 = lseb[row * 12 + 8 + jj]; const float mx = fmaxf(l0, fmaxf(l1, l2));
                    const float e0 = __expf(l0 - mx), e1 = __expf(l1 - mx), e2 = __expf(l2 - mx); const float al = (g == 0 ? e0 : (g == 1 ? e1 : e2)) / (e0 + e1 + e2);
                    v4u w = *(v4u*)(obuf + (size_t)i * 8); v4u o;
#define SC2(x) pk2(st16::lo(x) * al, st16::hi(x) * al)
                    o.x = SC2(w.x); o.y = SC2(w.y); o.z = SC2(w.z); o.w = SC2(w.w);
#undef SC2
                    *(v4u*)(obuf + (size_t)i * 8) = o; }
            }
            PH_END;
        }
        PH_IF {
            const int Ko = kind == 1 ? 1536 : 2048;
            pg8::Gemm g{obuf + (size_t)r0 * Ko, (const bf16*)(wl + WL_MO), MG, DM, Ko}; pg8::GroupOrder S; S.init(MG, DM, GL, lb, nxl, 4);
            pg8::EpiResid E{xb, ssb + (size_t)(4 * L + 2) * MT, kind == 2 ? args.in[15] + jm * DM : nullptr, r0};
            pg8::gemm_phase<pg8::EpiResid, pg8::GroupOrder, true, true>(lds + RING_OFF, g, S, E, wave);
        }
        PH_END;
        PH_IF {
            if (L == 0 && lb >= GL / 2) {
                pg8::Gemm g{memb + (size_t)mr0 * DM, (const bf16*)(ws + WS_WKV), MMG, 4096, DM}; pg8::GroupOrder S; S.init(MMG, 4096, GL / 2, lb - GL / 2, nxl);
                const pg8::EpiProj E{kvm, (size_t)MMEM * 2048, 2048, 2048, 8, 1 << 30, ssmem, nullptr, 1.0f, 0, nullptr, mr0, 1};
                pg8::gemm_phase<pg8::EpiProj, pg8::GroupOrder, true, true>(lds + RING_OFF, g, S, E, wave);
            }
            pg8::Gemm g{xb + (size_t)r0 * DM, (const bf16*)(wl + WL_XQ), MG, 512, DM}; pg8::GroupOrder S; S.init(MG, 512, GL, lb, nxl);
            const pg8::EpiProj E{xqbuf, 0, 512, 512, 1 << 30, 1 << 30, ssb + (size_t)(4 * L + 2) * MT, nullptr, 0.08838834764831845f * 1.4426950408889634f, 0, nullptr, r0, 1 | (4 << 4)};
            pg8::gemm_phase<pg8::EpiProj, pg8::GroupOrder, true, true>(lds + RING_OFF, g, S, E, wave);
        }
        PH_END;
        PH_IF for (int rep_ = 0; rep_ < ((ATT_REP_KIND < 0 || ATT_REP_KIND == 3) ? ATT_REP : 1); ++rep_) {
            LANE_ID(lane);
            for (int u = lwv; u < BG * 512; u += NLW) {
                const int qb = u & 127, h = (u >> 7) & 3, b = gidx * BG + (u >> 9); const size_t qrow = (size_t)b * SEQ + 32 * qb;
                wa::SmUnit U; U.q = nullptr; U.k = nullptr; U.v = kvm + (size_t)MMEM * 2048 + (size_t)b * NMEM * 2048 + L * 512 + h * 128; U.o = xobuf + qrow * 512 + h * 128;
                U.qt = xqbuf + ((size_t)(b * 4 + h) * 128 + qb) * 4096; U.kt = kvm + (size_t)(b * 16 + L * 4 + h) * 8 * 4096; U.ntiles = 8;
                U.qstride = 512; U.kstride = 2048; U.vstride = 2048; U.ostride = 512; U.qpos0 = 32 * qb; U.kpos0 = 0; U.nkeys = NMEM; U.maxdist = 1 << 30; U.causal = 0; U.sink = 0.f; U.lse = nullptr; U.lsestride = 0;
#ifndef MK_NO_XA
                wa::sm_unit<128, XA_TPC, 8 / XA_TPC, false, false, true>(U, vl, lane);
#endif
            }
        }
        PH_END;
        PH_IF {
            pg8::Gemm g{xobuf + (size_t)r0 * 512, (const bf16*)(wl + WL_XO), MG, DM, 512}; pg8::GroupOrder S; S.init(MG, DM, GL, lb, nxl, 4);
            pg8::EpiResid E{xb, ssb + (size_t)(4 * L + 3) * MT, nullptr, r0};
            pg8::gemm_phase<pg8::EpiResid, pg8::GroupOrder, true, true>(lds + RING_OFF, g, S, E, wave);
        }
        PH_END;
    }
    PH_IF {
        LANE_ID(lane);
        const pg8::ssq_t* ssf = ssb + (size_t)16 * MT; const f32x4* gn = (const f32x4*)args.in[24] + lane;
        for (int m = r0 + lwv; m < r0 + MG; m += NLW) { const float ri = pg8::rinv_of(ssf, m); f32x4* xr = (f32x4*)(xout + (size_t)m * DM) + lane; const v2u* xi = (const v2u*)(xb + (size_t)m * DM) + lane;
#pragma unroll
            for (int j = 0; j < 8; ++j) { const v2u w = xi[64 * j]; const f32x4 gg = gn[64 * j];
                f32x4 v; v[0] = st16::lo(w.x); v[1] = st16::hi(w.x); v[2] = st16::lo(w.y); v[3] = st16::hi(w.y);
                xr[64 * j] = v * ri * gg; } }
    }
    PH_END;
#undef PH_IF
#undef PH_END
}

extern "C" void kernel_launch(void* const* d_in, const int* in_sizes, int n_in, void* d_out, int out_size, void* d_ws, size_t ws_size, hipStream_t stream) {
    static int grid = 0;
    if (grid == 0) {
        if (n_in != 25 || out_size != MT * DM || ws_size < WS_END) { fprintf(stderr, "kernel_launch: unexpected shapes (n_in %d, out %d, ws %zu < %zu); nothing launched\n", n_in, out_size, ws_size, (size_t)WS_END); grid = -1; return; }
        int dev = 0, cus = 0, per_cu = 0;
        if (hipGetDevice(&dev) != hipSuccess || hipDeviceGetAttribute(&cus, hipDeviceAttributeMultiprocessorCount, dev) != hipSuccess) { fprintf(stderr, "kernel_launch: device query failed\n"); grid = -1; return; }
        if (hipFuncSetAttribute((const void*)mk_fwd, hipFuncAttributeMaxDynamicSharedMemorySize, LDS_BYTES) != hipSuccess) { fprintf(stderr, "kernel_launch: hipFuncSetAttribute failed\n"); grid = -1; return; }
        if (hipOccupancyMaxActiveBlocksPerMultiprocessor(&per_cu, (const void*)mk_fwd, NWAVES * 64, LDS_BYTES) != hipSuccess || per_cu < 1)
            fprintf(stderr, "kernel_launch: note: occupancy query reports %d workgroups per CU\n", per_cu);
        (void)hipGetLastError();
        grid = cus;
    }
    if (grid < 0) return;
    if (hipMemsetAsync((char*)d_ws + WS_CTL, 0, ZERO_BYTES, stream) != hipSuccess) { fprintf(stderr, "kernel_launch: memset failed\n"); return; }
    Args a{};
    for (int i = 0; i < 25; ++i) a.in[i] = (const float*)d_in[i];
    a.out = (float*)d_out; a.ws = (unsigned char*)d_ws;
#if MK_ONE_LAUNCH
    a.lo = 0; a.hi = NPHASES;
    hipLaunchKernelGGL(mk_fwd, dim3(grid), dim3(NWAVES * 64), LDS_BYTES, stream, a);
#else
    for (int p = 0; p < NPHASES; ++p) { a.lo = p; a.hi = p + 1; hipLaunchKernelGGL(mk_fwd, dim3(grid), dim3(NWAVES * 64), LDS_BYTES, stream, a); }
#endif
    const hipError_t le = hipPeekAtLastError();
    if (le != hipSuccess) fprintf(stderr, "kernel_launch: launch failed: %s\n", hipGetErrorName(le));
}
```

```cpp
#include <hip/hip_runtime.h>
#include <cstdio>
#include <cstdint>
#include <cmath>
#ifndef MK_F16
#define MK_F16 0
#endif
namespace st16 {
typedef short s16x8 __attribute__((ext_vector_type(8)));
typedef float v4f __attribute__((ext_vector_type(4)));
typedef float v16f __attribute__((ext_vector_type(16)));
#if MK_F16
typedef _Float16 h16x8 __attribute__((ext_vector_type(8)));
typedef _Float16 h16x2 __attribute__((ext_vector_type(2)));
typedef float v2f __attribute__((ext_vector_type(2)));
__device__ __forceinline__ unsigned pack(float lo, float hi) { unsigned r; asm volatile("v_cvt_pk_f16_f32 %0, %1, %2" : "=v"(r) : "v"(lo), "v"(hi)); return r; }
__device__ __forceinline__ float lo(unsigned w) { return (float)__builtin_bit_cast(h16x2, w)[0]; }
__device__ __forceinline__ float hi(unsigned w) { return (float)__builtin_bit_cast(h16x2, w)[1]; }
__device__ __forceinline__ v4f mfma16(s16x8 a, s16x8 b, v4f c) { return __builtin_amdgcn_mfma_f32_16x16x32_f16(__builtin_bit_cast(h16x8, a), __builtin_bit_cast(h16x8, b), c, 0, 0, 0); }
__device__ __forceinline__ v16f mfma32(s16x8 a, s16x8 b, v16f c) { return __builtin_amdgcn_mfma_f32_32x32x16_f16(__builtin_bit_cast(h16x8, a), __builtin_bit_cast(h16x8, b), c, 0, 0, 0); }
#else
__device__ __forceinline__ unsigned pack(float lo, float hi) { unsigned r; asm volatile("v_cvt_pk_bf16_f32 %0, %1, %2" : "=v"(r) : "v"(lo), "v"(hi)); return r; }
__device__ __forceinline__ float lo(unsigned w) { return __uint_as_float(w << 16); }
__device__ __forceinline__ float hi(unsigned w) { return __uint_as_float(w & 0xffff0000u); }
__device__ __forceinline__ v4f mfma16(s16x8 a, s16x8 b, v4f c) { return __builtin_amdgcn_mfma_f32_16x16x32_bf16(a, b, c, 0, 0, 0); }
__device__ __forceinline__ v16f mfma32(s16x8 a, s16x8 b, v16f c) { return __builtin_amdgcn_mfma_f32_32x32x16_bf16(a, b, c, 0, 0, 0); }
#endif
}

namespace pg8 {
#define PG8_LAS __attribute__((address_space(3)))
typedef unsigned short bf16_t;
typedef short bf16x8 __attribute__((ext_vector_type(8)));
typedef float f32x4 __attribute__((ext_vector_type(4)));
typedef unsigned u32x4 __attribute__((ext_vector_type(4)));
constexpr int BM = 256, BK = 64, HALF = 128, HTB = HALF * BK * 2  , STAGE_BYTES = 8 * HTB, NXCD = 8, WGM = 8;

__host__ __device__ __forceinline__ int lds_byte(int r, int c) { const int st = (r >> 4) * 2 + (c >> 5), rr = r & 15, cc = c & 31, ob = rr * 64 + cc * 2; return st * 1024 + (ob ^ (((ob >> 9) & 1) << 5)); }
__host__ __device__ __forceinline__ void stage_rc(int b, int& R, int& C) { const int st = b / 1024, sb = b % 1024, swz = sb ^ (((sb >> 9) & 1) << 5); R = (st >> 1) * 16 + swz / 64; C = (st & 1) * 32 + (swz % 64) / 2; }
__host__ __device__ __forceinline__ int perm32(int rho) { const int n = rho >> 4, i = rho & 15; return 8 * (i >> 2) + 4 * n + (i & 3); }

struct Unit { int pm, pn; };
struct Gemm { const bf16_t* A; const bf16_t* Bt; int M, N, K; };

struct StaticOrder {
    int nM, nN, nwg, G, c;
    __host__ __device__ void init(int M, int N, int G_, int c_) { nM = M / BM; nN = N / BM; nwg = nM * nN; G = G_; c = c_; }
    __host__ __device__ bool next(int i, Unit& u) const {
        const long L = (long)i * G + c; if (L >= nwg) return false;
        int wgid = (int)L; { const int q = nwg / NXCD, r = nwg % NXCD, xcd = wgid % NXCD, off = wgid / NXCD; wgid = (xcd < r ? xcd * (q + 1) : r * (q + 1) + (xcd - r) * q) + off; }
        const int nig = WGM * nN, gid = wgid / nig, fm = gid * WGM, gsz = (nM - fm) < WGM ? (nM - fm) : WGM;
        u.pm = fm + ((wgid % nig) % gsz); u.pn = (wgid % nig) / gsz; return true;
    }
    __device__ __forceinline__ void a_ready(const Unit&) const {}
    __device__ __forceinline__ void done(const Unit&) const {}
};
struct GroupOrder {
    int nM, nN, nwg, G, c, nx, wgm;
    __host__ __device__ void init(int M, int N, int G_, int c_, int nx_, int wgm_ = WGM) { nM = M / BM; nN = N / BM; nwg = nM * nN; G = G_; c = c_; nx = nx_; wgm = wgm_; }
    __host__ __device__ bool next(int i, Unit& u) const {
        const long L = (long)i * G + c; if (L >= nwg) return false;
        int wgid = (int)L; { const int q = nwg / nx, r = nwg % nx, xcd = wgid % nx, off = wgid / nx; wgid = (xcd < r ? xcd * (q + 1) : r * (q + 1) + (xcd - r) * q) + off; }
        const int nig = wgm * nN, gid = wgid / nig, fm = gid * wgm, gsz = (nM - fm) < wgm ? (nM - fm) : wgm;
        u.pm = fm + ((wgid % nig) % gsz); u.pn = (wgid % nig) / gsz; return true;
    }
    __device__ __forceinline__ void a_ready(const Unit&) const {}
    __device__ __forceinline__ void done(const Unit&) const {}
};

__device__ __forceinline__ unsigned cvt_pk_bf16(float lo, float hi) { return st16::pack(lo, hi); }
typedef float f32x2 __attribute__((ext_vector_type(2)));
constexpr float RMS_EPS = 1e-6f, INV_D = 1.0f / 2048.0f, LOG2E = 1.4426950408889634f;
typedef unsigned long long ssq_t;
constexpr float SSQ_SCALE = 16777216.0f;
__device__ __forceinline__ ssq_t ssq_fix(float s) { return (ssq_t)(s * SSQ_SCALE + 0.5f); }
__device__ __forceinline__ float rinv_from(ssq_t s) { const float sf = (float)(unsigned)(s >> 32) * 4294967296.0f + (float)(unsigned)s; return __builtin_amdgcn_rsqf(sf * (INV_D / SSQ_SCALE) + RMS_EPS); }
__device__ __forceinline__ float rinv_of(const ssq_t* ss, int row) { const ssq_t s = ss[row]; const float sf = (float)(unsigned)(s >> 32) * 4294967296.0f + (float)(unsigned)s;
    return __builtin_amdgcn_rsqf(sf * (INV_D / SSQ_SCALE) + RMS_EPS); }

struct PreRinv { float ri[8]; };
struct PreNone {};
#ifndef EPI_REP
#define EPI_REP 1
#endif
struct EpiSwiGLU {
    static constexpr bool PERM = true, AFTER_DRAIN = false; static constexpr int REP = EPI_REP;
    bf16_t* O; int ldc; const ssq_t* ss; int roff;
    typedef PreNone Pre;
    __device__ __forceinline__ void prefetch(Pre&, const Unit&, int, int, int, int) const {}
    struct Nx { ssq_t a, b; };
    __device__ __forceinline__ void nx_issue(Nx& x, const Unit& u, int wr, int lane) const { const ssq_t* p = ss + roff + u.pm * BM + wr * 64 + lane; x.a = p[0]; x.b = p[HALF]; }
    __device__ __forceinline__ void nx_commit(const Nx& x, PG8_LAS float* slot, int lane) const { slot[lane] = rinv_from(x.a); slot[64 + lane] = rinv_from(x.b); }
    __device__ __forceinline__ void operator()(const f32x4 (&acc)[2][2][4][2], const Unit& u, int wr, int wc, int fr, int fq, const Pre&, const PG8_LAS float* slot) const {
        const int row0 = roff + u.pm * BM + wr * 64 + fr, col0 = u.pn * HALF + wc * 32 + 8 * fq;
#pragma unroll
        for (int ai = 0; ai < 2; ++ai)
#pragma unroll
            for (int m = 0; m < 4; ++m) { const int r = row0 + ai * HALF + m * 16; const float ri = slot[ai * 64 + m * 16 + fr], rl = ri * (-LOG2E), rq = ri * ri;
                float h[8];
#pragma unroll
                for (int n = 0; n < 2; ++n)
#pragma unroll
                    for (int j = 0; j < 4; j += 2) {
                        const f32x2 g = (f32x2){acc[ai][0][m][n][j], acc[ai][0][m][n][j + 1]}, uu = (f32x2){acc[ai][1][m][n][j], acc[ai][1][m][n][j + 1]};
                        const f32x2 t = g * rl; f32x2 e; e.x = __builtin_amdgcn_exp2f(t.x); e.y = __builtin_amdgcn_exp2f(t.y);
                        const f32x2 d = e + 1.0f; f32x2 rc; rc.x = __builtin_amdgcn_rcpf(d.x); rc.y = __builtin_amdgcn_rcpf(d.y);
                        const f32x2 hv = (g * uu) * (rc * rq); h[4 * n + j] = hv.x; h[4 * n + j + 1] = hv.y; }
                u32x4 w; w.x = cvt_pk_bf16(h[0], h[1]); w.y = cvt_pk_bf16(h[2], h[3]); w.z = cvt_pk_bf16(h[4], h[5]); w.w = cvt_pk_bf16(h[6], h[7]);
                *(u32x4*)(O + (size_t)r * ldc + col0) = w; }
    }
};

struct EpiResid {
    static constexpr bool PERM = true, AFTER_DRAIN = false; static constexpr int REP = 1;
    bf16_t* xb; ssq_t* ssn; const float* bias; int roff;
    typedef PreNone Pre;
    __device__ __forceinline__ void prefetch(Pre&, const Unit&, int, int, int, int) const {}
    struct Nx {};
    __device__ __forceinline__ void nx_issue(Nx&, const Unit&, int, int) const {}
    __device__ __forceinline__ void nx_commit(const Nx&, PG8_LAS float*, int) const {}
    __device__ __forceinline__ void operator()(const f32x4 (&acc)[2][2][4][2], const Unit& u, int wr, int wc, int fr, int fq, const Pre&, const PG8_LAS float*) const {
        const int row0 = roff + u.pm * BM + wr * 64 + fr, col0 = u.pn * BM + wc * 32 + 8 * fq;
        f32x4 bv[2][2];
#pragma unroll
        for (int bj = 0; bj < 2; ++bj)
#pragma unroll
            for (int n = 0; n < 2; ++n) bv[bj][n] = bias ? *(const f32x4*)(bias + col0 + bj * HALF + 4 * n) : (f32x4){0.f, 0.f, 0.f, 0.f};
#pragma unroll
        for (int ai = 0; ai < 2; ++ai)
#pragma unroll
            for (int m = 0; m < 4; ++m) { const int r = row0 + ai * HALF + m * 16; float sq = 0.f;
#pragma unroll
                for (int bj = 0; bj < 2; ++bj) { bf16_t* p = xb + (size_t)r * 2048 + col0 + bj * HALF;
                    const u32x4 xo = *(const u32x4*)p;
                    f32x4 v0, v1;
                    v0[0] = st16::lo(xo.x); v0[1] = st16::hi(xo.x); v0[2] = st16::lo(xo.y); v0[3] = st16::hi(xo.y);
                    v1[0] = st16::lo(xo.z); v1[1] = st16::hi(xo.z); v1[2] = st16::lo(xo.w); v1[3] = st16::hi(xo.w);
                    v0 = v0 + acc[ai][bj][m][0] + bv[bj][0]; v1 = v1 + acc[ai][bj][m][1] + bv[bj][1];
                    u32x4 w; w.x = cvt_pk_bf16(v0[0], v0[1]); w.y = cvt_pk_bf16(v0[2], v0[3]); w.z = cvt_pk_bf16(v1[0], v1[1]); w.w = cvt_pk_bf16(v1[2], v1[3]);
                    *(u32x4*)p = w;
                    sq += (v0[0] * v0[0] + v0[1] * v0[1]) + (v0[2] * v0[2] + v0[3] * v0[3]) + (v1[0] * v1[0] + v1[1] * v1[1]) + (v1[2] * v1[2] + v1[3] * v1[3]); }
                sq += __shfl_xor(sq, 16); sq += __shfl_xor(sq, 32);
                if (fq == 0) atomicAdd(ssn + r, ssq_fix(sq)); }
    }
};

struct EpiProj {
    static constexpr bool PERM = true, AFTER_DRAIN = false; static constexpr int REP = 1;
    bf16_t* d0; size_t tstride; int ld0, ld12, t1, t2; const ssq_t* ss; const float* bias; float qscale; int hd; const float* rtab; int roff; int tl;
    typedef PreNone Pre;
    __device__ __forceinline__ void prefetch(Pre&, const Unit&, int, int, int, int) const {}
    struct Nx { ssq_t a, b; };
    __device__ __forceinline__ void nx_issue(Nx& x, const Unit& u, int wr, int lane) const { const ssq_t* p = ss + roff + u.pm * BM + wr * 64 + lane; x.a = p[0]; x.b = p[HALF]; }
    __device__ __forceinline__ void nx_commit(const Nx& x, PG8_LAS float* slot, int lane) const { slot[lane] = rinv_from(x.a); slot[64 + lane] = rinv_from(x.b); }
    __device__ __forceinline__ void operator()(const f32x4 (&acc)[2][2][4][2], const Unit& u, int wr, int wc, int fr, int fq, const Pre&, const PG8_LAS float* slot) const {
        const int pn = u.pn; const int tsel = pn >= t2 ? 2 : (pn >= t1 ? 1 : 0);
        bf16_t* base = d0 + (size_t)tsel * tstride; const int ld = tsel == 0 ? ld0 : ld12; const int tf = pn >= t2 ? t2 : (pn >= t1 ? t1 : 0);
        const float sc = tsel == 0 ? qscale : 1.0f;
        const int row0 = roff + u.pm * BM + wr * 64 + fr, col0 = (pn - tf) * BM + wc * 32 + 8 * fq, gcol0 = pn * BM + wc * 32 + 8 * fq;
        const bool rotw = (hd != 0) && (tsel < 2) && (hd == 128 ? (wc == 0) : ((wc & 1) == 0));
        const bool rotl = (hd == 128) ? true : (fq < 2);
        const int half = hd >> 3, xr = hd >> 2;
        const int ii0 = (hd == 128) ? 8 * (fq & 1) : 0;
        const float sgn = ((hd == 128) ? (fq < 2) : (fq == 0)) ? -1.0f : 1.0f;
#pragma unroll
        for (int ai = 0; ai < 2; ++ai)
#pragma unroll
            for (int m = 0; m < 4; ++m) { const int r = row0 + ai * HALF + m * 16; const float ri = slot[ai * 64 + m * 16 + fr];
                f32x4 cs[4];
                if (rotw) { const f32x4* tp = (const f32x4*)(rtab + ((size_t)r * half + ii0) * 2);
#pragma unroll
                    for (int q = 0; q < 4; ++q) cs[q] = tp[q]; }
#pragma unroll
                for (int bj = 0; bj < 2; ++bj) { float v[8];
                    f32x4 b0 = (f32x4){0.f, 0.f, 0.f, 0.f}, b1 = b0;
                    if (bias) { b0 = *(const f32x4*)(bias + gcol0 + bj * HALF); b1 = *(const f32x4*)(bias + gcol0 + bj * HALF + 4); }
#pragma unroll
                    for (int j = 0; j < 4; ++j) { v[j] = acc[ai][bj][m][0][j] * ri + b0[j]; v[4 + j] = acc[ai][bj][m][1][j] * ri + b1[j]; }
                    if (rotw) {
#pragma unroll
                        for (int i = 0; i < 8; ++i) { const float o = __shfl_xor(v[i], xr); const float c = cs[i >> 1][2 * (i & 1)], s = cs[i >> 1][2 * (i & 1) + 1];
                            const float nv = v[i] * c + sgn * o * s; v[i] = rotl ? nv : v[i]; } }
                    u32x4 w; w.x = cvt_pk_bf16(v[0] * sc, v[1] * sc); w.y = cvt_pk_bf16(v[2] * sc, v[3] * sc); w.z = cvt_pk_bf16(v[4] * sc, v[5] * sc); w.w = cvt_pk_bf16(v[6] * sc, v[7] * sc);
                    const int cq = col0 + bj * HALF;
                    unsigned off = (unsigned)r * (unsigned)ld + (unsigned)cq;
                    if ((tl >> tsel) & 1) {
                        const int hdl = (tl & 512) ? 6 : 7;
                        const int lsq = 8 + ((tl >> 4) & 15), H = ld >> hdl, head = __builtin_amdgcn_readfirstlane(cq >> hdl), cc = cq & ((1 << hdl) - 1);
                        const int l2d = (tl & 256) ? 2 * (head >> 2) : 0;
                        const unsigned b = (unsigned)r >> lsq, pos = (unsigned)r & ((1u << lsq) - 1u), a = pos >> l2d, p = pos & ((1u << l2d) - 1u), ft = (p << (lsq - l2d - 5)) + (a >> 5);
                        off = ((((b * (unsigned)H + (unsigned)head) << (lsq - 5)) + ft) * (unsigned)(1 << (hdl - 4)) + (unsigned)(cc >> 4)) * 512u + (unsigned)(((cc >> 3) & 1) * 32) * 8u + (a & 31u) * 8u; }
                    *(u32x4*)(base + off) = w; } }
    }
};

#ifndef ZERO_REP
#define ZERO_REP 1
#endif
constexpr int PG8_NX_OFF = 137216;
template <class Epi, class Sched, bool ALIGN_EPI = false, bool SP2 = false>
__device__ __forceinline__ void gemm_phase(PG8_LAS unsigned char* lds, const Gemm g, const Sched& S, const Epi& E, const int wave_in) {
    int tid0; asm volatile("v_mbcnt_lo_u32_b32 %0, -1, 0\n\tv_mbcnt_hi_u32_b32 %0, -1, %0" : "=v"(tid0)); tid0 += wave_in * 64;
    const int tid = tid0, wid = __builtin_amdgcn_readfirstlane(tid >> 6), lane = tid & 63, wr = wid >> 2, wc = wid & 3, fr = lane & 15, fq = lane >> 4;
    const int K = g.K, nt = K / BK;
    unsigned voffA[2], voffB[2];
#pragma unroll
    for (int i = 0; i < 2; ++i) { int R, C; stage_rc(tid * 16 + i * 8192, R, C); const int Rb = Epi::PERM ? ((R & ~31) + perm32(R & 31)) : R;
        voffA[i] = (unsigned)(R * K + C) * 2u; voffB[i] = (unsigned)(Rb * K + C) * 2u; }
    const size_t kstep = (size_t)(BK * 2);
    const size_t hstep = (size_t)HALF * K * 2;
    const size_t tstep = 2 * hstep;
    const unsigned ldsw = (unsigned)wid * 1024u;
    const int aoff = lds_byte(wr * 64 + fr, fq * 8), boff = lds_byte(wc * 32 + fr, fq * 8);
#define PG8_SA(b, h) (((b) * 2 + (h)) * HTB)
#define PG8_SB(b, h) ((4 + (b) * 2 + (h)) * HTB)
#define PG8_STAGE(bufoff, gbase, voff) do { _Pragma("unroll") for (int _i = 0; _i < 2; ++_i) \
        __builtin_amdgcn_global_load_lds((const unsigned*)((const char*)(gbase) + (voff)[_i]), (PG8_LAS unsigned*)(lds + (bufoff) + ldsw + _i * 8192), 16, 0, 0); } while (0)
#define PG8_LDA(dst, b, h) do { _Pragma("unroll") for (int m = 0; m < 4; ++m) _Pragma("unroll") for (int k = 0; k < 2; ++k) dst[m][k] = *(const PG8_LAS bf16x8*)(lds + PG8_SA(b, h) + aoff + m * 2048 + k * 1024); } while (0)
#define PG8_LDB(dst, b, h) do { _Pragma("unroll") for (int n = 0; n < 2; ++n) _Pragma("unroll") for (int k = 0; k < 2; ++k) dst[n][k] = *(const PG8_LAS bf16x8*)(lds + PG8_SB(b, h) + boff + n * 2048 + k * 1024); } while (0)
#define PG8_MMA(ai, bj, At, Bt) do { __builtin_amdgcn_s_setprio(1); _Pragma("unroll") for (int m = 0; m < 4; ++m) _Pragma("unroll") for (int n = 0; n < 2; ++n) _Pragma("unroll") for (int k = 0; k < 2; ++k) \
        acc[ai][bj][m][n] = st16::mfma16(Bt[n][k], At[m][k], acc[ai][bj][m][n]); __builtin_amdgcn_s_setprio(0); } while (0)
#define PG8_WAIT_V(n) asm volatile("s_waitcnt vmcnt(" #n ")" ::: "memory")
#define PG8_WAIT_L(n) asm volatile("s_waitcnt lgkmcnt(" #n ")" ::: "memory")
#define PG8_BAR __builtin_amdgcn_s_barrier()
#define PG8_SCHED __builtin_amdgcn_sched_barrier(0)
    typedef float f32x2z __attribute__((ext_vector_type(2)));
    Unit cur, nxt; int ui = 0;
    if (!S.next(0, cur)) return;
    f32x4 acc[2][2][4][2];
    typename Epi::Pre pre;
#pragma unroll
    for (int a = 0; a < 2; ++a)
#pragma unroll
        for (int b = 0; b < 2; ++b)
#pragma unroll
            for (int m = 0; m < 4; ++m)
#pragma unroll
                for (int n = 0; n < 2; ++n) { f32x2z z0_, z1_; asm volatile("v_mov_b64 %0, 0" : "=v"(z0_)); asm volatile("v_mov_b64 %0, 0" : "=v"(z1_));
                    acc[a][b][m][n] = (f32x4){z0_[0], z0_[1], z1_[0], z1_[1]}; }
    bf16x8 At[4][2], B0[2][2], B1[2][2];
    const char* cA = (const char*)g.A + (size_t)cur.pm * tstep; const char* cB = (const char*)g.Bt + (size_t)cur.pn * tstep;
    S.a_ready(cur);
    PG8_LAS float* const nxslot = (PG8_LAS float*)(lds + PG8_NX_OFF + wid * 1024);
    typename Epi::Nx nx0; E.nx_issue(nx0, cur, wr, lane); E.nx_commit(nx0, nxslot, lane);
    if constexpr (SP2) {
        PG8_STAGE(PG8_SB(0, 0), cB, voffB); PG8_STAGE(PG8_SB(0, 1), cB + hstep, voffB); PG8_STAGE(PG8_SA(0, 0), cA, voffA); PG8_STAGE(PG8_SA(0, 1), cA + hstep, voffA);
        if (wr == 1) PG8_BAR;
        PG8_WAIT_V(2); PG8_BAR;
        PG8_STAGE(PG8_SB(1, 0), cB + kstep, voffB); PG8_STAGE(PG8_SA(1, 0), cA + kstep, voffA); PG8_STAGE(PG8_SB(1, 1), cB + hstep + kstep, voffB);
        PG8_WAIT_V(6); PG8_BAR;
    } else {
        PG8_STAGE(PG8_SB(0, 0), cB, voffB); PG8_STAGE(PG8_SA(0, 0), cA, voffA); PG8_STAGE(PG8_SB(0, 1), cB + hstep, voffB); PG8_STAGE(PG8_SA(0, 1), cA + hstep, voffA);
        if (wr == 1) PG8_BAR;
        PG8_WAIT_V(4); PG8_BAR;
        PG8_STAGE(PG8_SB(1, 0), cB + kstep, voffB); PG8_STAGE(PG8_SA(1, 0), cA + kstep, voffA); PG8_STAGE(PG8_SB(1, 1), cB + hstep + kstep, voffB);
        PG8_WAIT_V(6); PG8_BAR;
    }
    for (;;) {
        const bool has_next = S.next(ui + 1, nxt);
        const char* nA = has_next ? (const char*)g.A + (size_t)nxt.pm * tstep : cA; const char* nB = has_next ? (const char*)g.Bt + (size_t)nxt.pn * tstep : cB;
        for (int t = 0; t < nt; t += 2) {
            const bool last = (t == nt - 2);
            const char* a1 = cA + (size_t)(t + 1) * kstep;
            const char* a2 = last ? nA : cA + (size_t)(t + 2) * kstep; const char* b2 = last ? nB : cB + (size_t)(t + 2) * kstep;
            const char* a3 = a2 + kstep; const char* b3 = b2 + kstep;
            if (last && has_next) S.a_ready(nxt);
            if (last) E.prefetch(pre, cur, wr, wc, fr, fq);
            if constexpr (SP2) {
            PG8_LDB(B0, 0, 0); PG8_LDB(B1, 0, 1); PG8_SCHED; PG8_LDA(At, 0, 0); PG8_STAGE(PG8_SA(1, 1), a1 + hstep, voffA);
            PG8_WAIT_V(8); PG8_WAIT_L(0); PG8_BAR; PG8_MMA(0, 0, At, B0); PG8_MMA(0, 1, At, B1); PG8_BAR; PG8_SCHED;
            PG8_LDA(At, 0, 1); PG8_STAGE(PG8_SB(0, 0), b2, voffB); PG8_STAGE(PG8_SB(0, 1), b2 + hstep, voffB); PG8_STAGE(PG8_SA(0, 0), a2, voffA);
            PG8_WAIT_V(8); PG8_WAIT_L(0); PG8_BAR; PG8_MMA(1, 0, At, B0); PG8_MMA(1, 1, At, B1); PG8_BAR; PG8_SCHED;
            PG8_LDB(B0, 1, 0); PG8_LDB(B1, 1, 1); PG8_SCHED; PG8_LDA(At, 1, 0); PG8_STAGE(PG8_SA(0, 1), a2 + hstep, voffA);
            PG8_WAIT_V(8); PG8_WAIT_L(0); PG8_BAR; PG8_MMA(0, 0, At, B0); PG8_MMA(0, 1, At, B1); PG8_BAR; PG8_SCHED;
            PG8_LDA(At, 1, 1); PG8_STAGE(PG8_SB(1, 0), b3, voffB); PG8_STAGE(PG8_SB(1, 1), b3 + hstep, voffB); PG8_STAGE(PG8_SA(1, 0), a3, voffA);
            PG8_WAIT_V(8); PG8_WAIT_L(0); PG8_BAR; PG8_MMA(1, 0, At, B0); PG8_MMA(1, 1, At, B1); PG8_BAR; PG8_SCHED;
            } else {
            PG8_LDB(B0, 0, 0); PG8_SCHED; PG8_LDA(At, 0, 0); PG8_STAGE(PG8_SA(1, 1), a1 + hstep, voffA);
            PG8_WAIT_L(8); PG8_BAR; PG8_WAIT_L(0); PG8_MMA(0, 0, At, B0); PG8_BAR; PG8_SCHED;
            PG8_LDB(B1, 0, 1); PG8_STAGE(PG8_SB(0, 0), b2, voffB);
            PG8_BAR; PG8_WAIT_L(0); PG8_MMA(0, 1, At, B1); PG8_BAR;
            PG8_LDA(At, 0, 1); PG8_STAGE(PG8_SA(0, 0), a2, voffA);
            PG8_BAR; PG8_WAIT_L(0); PG8_MMA(1, 0, At, B0); PG8_BAR; PG8_SCHED;
            PG8_STAGE(PG8_SB(0, 1), b2 + hstep, voffB);
            PG8_WAIT_V(6); PG8_BAR; PG8_MMA(1, 1, At, B1); PG8_BAR;
            PG8_LDB(B0, 1, 0); PG8_SCHED; PG8_LDA(At, 1, 0); PG8_STAGE(PG8_SA(0, 1), a2 + hstep, voffA);
            PG8_WAIT_L(8); PG8_BAR; PG8_WAIT_L(0); PG8_MMA(0, 0, At, B0); PG8_BAR; PG8_SCHED;
            PG8_LDB(B1, 1, 1); PG8_STAGE(PG8_SB(1, 0), b3, voffB);
            PG8_BAR; PG8_WAIT_L(0); PG8_MMA(0, 1, At, B1); PG8_BAR;
            PG8_LDA(At, 1, 1); PG8_STAGE(PG8_SA(1, 0), a3, voffA);
            PG8_BAR; PG8_WAIT_L(0); PG8_MMA(1, 0, At, B0); PG8_BAR; PG8_SCHED;
            PG8_STAGE(PG8_SB(1, 1), b3 + hstep, voffB);
            PG8_WAIT_V(6); PG8_BAR; PG8_MMA(1, 1, At, B1); PG8_BAR;
            }
        }
        if constexpr (ALIGN_EPI) { if (wr == 0) PG8_BAR; }
        if constexpr (!Epi::AFTER_DRAIN) {
            for (int er_ = 0; er_ < Epi::REP; ++er_) E(acc, cur, wr, wc, fr, fq, pre, nxslot);
            if (has_next && nxt.pm != cur.pm) { typename Epi::Nx nx1; E.nx_issue(nx1, nxt, wr, lane); E.nx_commit(nx1, nxslot, lane); }
            S.done(cur); }
        if (!has_next) break;
        for (int zr_ = 0; zr_ < ZERO_REP; ++zr_)
#pragma unroll
        for (int a = 0; a < 2; ++a)
#pragma unroll
            for (int b = 0; b < 2; ++b)
#pragma unroll
                for (int m = 0; m < 4; ++m)
#pragma unroll
                    for (int n = 0; n < 2; ++n) { f32x2z z0_, z1_; asm volatile("v_mov_b64 %0, 0" : "=v"(z0_)); asm volatile("v_mov_b64 %0, 0" : "=v"(z1_));
                    acc[a][b][m][n] = (f32x4){z0_[0], z0_[1], z1_[0], z1_[1]}; }
        cur = nxt; cA = nA; cB = nB; ++ui;
        if constexpr (ALIGN_EPI) { if (wr == 1) PG8_BAR; }
    }
    PG8_WAIT_V(0);
    if constexpr (!ALIGN_EPI) { if (wr == 0) PG8_BAR; }
    PG8_BAR;
    if constexpr (Epi::AFTER_DRAIN) { E.fused(acc, cur, wr, wc, fr, fq, lds, wid, lane); S.done(cur); }
#undef PG8_SA
#undef PG8_SB
#undef PG8_STAGE
#undef PG8_LDA
#undef PG8_LDB
#undef PG8_MMA
#undef PG8_WAIT_V
#undef PG8_WAIT_L
#undef PG8_BAR
#undef PG8_SCHED
}
}

namespace wa {
#ifndef WA_MASK_SKIP
#define WA_MASK_SKIP 1
#endif
#define WA_LAS __attribute__((address_space(3)))
typedef unsigned short bf16_t;
typedef short bf16x8 __attribute__((ext_vector_type(8)));
typedef short s16x4 __attribute__((ext_vector_type(4)));
typedef float f32x16 __attribute__((ext_vector_type(16)));
typedef float f32x4 __attribute__((ext_vector_type(4)));
typedef unsigned u32x4 __attribute__((ext_vector_type(4)));
typedef unsigned u32x2 __attribute__((ext_vector_type(2)));
constexpr float LOG2E = 1.4426950408889634f, LN2 = 0.6931471805599453f;
__device__ __forceinline__ unsigned cvtpk(float lo, float hi) { return st16::pack(lo, hi); }
__device__ __forceinline__ s16x4 vtr(const WA_LAS unsigned char* p) { return __builtin_bit_cast(s16x4, __builtin_amdgcn_ds_read_tr16_b64_v4i16((WA_LAS s16x4*)p)); }
__device__ __forceinline__ int kofs(int reg, int hh) { return (reg & 3) + 8 * (reg >> 2) + 4 * hh; }

template <int HD> struct VRegs { u32x4 t[32 / (64 / (HD / 8))]; };
template <int HD> __device__ __forceinline__ void load_v(VRegs<HD>& R, const bf16_t* v, long vstride, int kp0, int nkeys, int lane) {
    constexpr int LPR = HD / 8  , RPI = 64 / LPR  ;
#pragma unroll
    for (int i = 0; i < 32 / RPI; ++i) { const int row = i * RPI + lane / LPR; int kp = kp0 + row; kp = kp < 0 ? 0 : (kp >= nkeys ? nkeys - 1 : kp);
        R.t[i] = *(const u32x4*)(v + (long)kp * vstride + (lane % LPR) * 8); }
}
template <int HD> __device__ __forceinline__ void write_v(const VRegs<HD>& R, WA_LAS unsigned char* vl, int lane) {
    constexpr int VP = HD * 2 + 64, LPR = HD / 8, RPI = 64 / LPR;
#pragma unroll
    for (int i = 0; i < 32 / RPI; ++i) { const int row = i * RPI + lane / LPR; *(WA_LAS u32x4*)(vl + row * VP + (lane % LPR) * 16) = R.t[i]; }
}
template <int HD> __device__ __forceinline__ void stage_v(WA_LAS unsigned char* vl, const bf16_t* v, long vstride, int kp0, int nkeys, int lane) {
    VRegs<HD> R; load_v<HD>(R, v, vstride, kp0, nkeys, lane); write_v<HD>(R, vl, lane);
}
template <int HD> __device__ __forceinline__ void pv_tile(f32x16 (&o)[HD / 32], const f32x16& p, const WA_LAS unsigned char* vl, int lane) {
    constexpr int VP = HD * 2 + 64;
    const int hh = lane >> 5, i16 = lane & 15, q4 = i16 >> 2, p4 = i16 & 3, dsel = (lane >> 4) & 1;
    bf16x8 pb[2];
#pragma unroll
    for (int s2 = 0; s2 < 2; ++s2) { u32x4 w; w.x = cvtpk(p[8 * s2 + 0], p[8 * s2 + 1]); w.y = cvtpk(p[8 * s2 + 2], p[8 * s2 + 3]); w.z = cvtpk(p[8 * s2 + 4], p[8 * s2 + 5]); w.w = cvtpk(p[8 * s2 + 6], p[8 * s2 + 7]);
        pb[s2] = __builtin_bit_cast(bf16x8, w); }
    const WA_LAS unsigned char* base = vl + (4 * hh + q4) * VP + (16 * dsel + 4 * p4) * 2;
#pragma unroll
    for (int dc = 0; dc < HD / 32; ++dc)
#pragma unroll
        for (int s2 = 0; s2 < 2; ++s2) {
            const s16x4 lo = vtr(base + (16 * s2) * VP + dc * 64), hi = vtr(base + (16 * s2 + 8) * VP + dc * 64);
            const bf16x8 a = (bf16x8){lo[0], lo[1], lo[2], lo[3], hi[0], hi[1], hi[2], hi[3]};
            o[dc] = st16::mfma32(a, pb[s2], o[dc]);
        }
}
template <int HD> __device__ __forceinline__ void store_o(const f32x16 (&o)[HD / 32], float scale, bf16_t* orow, int hh) {
#pragma unroll
    for (int dc = 0; dc < HD / 32; ++dc)
#pragma unroll
        for (int g = 0; g < 4; ++g) { u32x2 w; w.x = cvtpk(o[dc][4 * g] * scale, o[dc][4 * g + 1] * scale); w.y = cvtpk(o[dc][4 * g + 2] * scale, o[dc][4 * g + 3] * scale);
            *(u32x2*)(orow + 32 * dc + 8 * g + 4 * hh) = w; }
}

#ifndef WA_OLDS_SM
#define WA_OLDS_SM 1
#endif
#ifndef WA_OLDS_SB
#define WA_OLDS_SB 1
#endif
template <int HD> __device__ __forceinline__ void store_o_lds(const f32x16 (&o)[HD / 32], float scale, bf16_t* obase, long ostride, WA_LAS unsigned char* vl, int lane) {
    constexpr int P = HD * 2 + 16, LPR = HD / 8, RPI = 64 / LPR;
    asm volatile("v_mbcnt_lo_u32_b32 %0, -1, 0\n\tv_mbcnt_hi_u32_b32 %0, -1, %0" : "=v"(lane));
    const int q = lane & 31, hh = lane >> 5;
#pragma unroll
    for (int dc = 0; dc < HD / 32; ++dc)
#pragma unroll
        for (int g = 0; g < 4; ++g) { u32x2 w; w.x = cvtpk(o[dc][4 * g] * scale, o[dc][4 * g + 1] * scale); w.y = cvtpk(o[dc][4 * g + 2] * scale, o[dc][4 * g + 3] * scale);
            *(WA_LAS u32x2*)(vl + q * P + (32 * dc + 8 * g + 4 * hh) * 2) = w; }
#pragma unroll
    for (int j = 0; j < 32 / RPI; ++j) { const int row = j * RPI + lane / LPR;
        const u32x4 w = *(const WA_LAS u32x4*)(vl + row * P + (lane % LPR) * 16);
        *(u32x4*)(obase + (long)row * ostride + (lane % LPR) * 8) = w; }
}

struct SmUnit {
    const bf16_t* q;
    const bf16_t* k;
    const bf16_t* v;
    bf16_t* o;
    long qstride, kstride, vstride, ostride;
    int qpos0, kpos0, nkeys, maxdist, causal;
    float sink;
    float* lse; long lsestride;
    const bf16_t* qt; const bf16_t* kt; int ntiles;
};
template <int HD, int TPC, int NCH, bool SINK, bool LSE, bool TIL, bool ROT = false>
__device__ __forceinline__ void sm_unit(const SmUnit& U, WA_LAS unsigned char* vl, int lane) {
    const int r = lane & 31, hh = lane >> 5;
    bf16x8 qf[HD / 16];
    { const bf16_t* qp = TIL ? U.qt + lane * 8 : U.q + (long)r * U.qstride + 8 * hh;
#pragma unroll
      for (int s = 0; s < HD / 16; ++s) qf[s] = *(const bf16x8*)(qp + (TIL ? 512 : 16) * s); }
    f32x16 o[HD / 32];
#pragma unroll
    for (int dc = 0; dc < HD / 32; ++dc)
#pragma unroll
        for (int i = 0; i < 16; ++i) o[dc][i] = 0.f;
    float m = -1e30f, l = 0.f;
    const int qpos = U.qpos0 + r;
    const int rot = ROT ? (((U.kpos0 >> 5) % TPC) + TPC) % TPC : 0;
#define WA_TT(tau_) ((tau_) - rot < 0 ? (tau_) - rot + TPC : (tau_) - rot)
#pragma unroll 1
    for (int ch = 0; ch < NCH; ++ch) {
        const int kb = U.kpos0 + ch * TPC * 32;
        f32x16 S[TPC];
        constexpr bool VPF = (NCH == 1);
        VRegs<HD> vr; if (VPF) load_v<HD>(vr, U.v, U.vstride, kb + 32 * WA_TT(0), U.nkeys, lane);
        bf16x8 kf[HD / 16];
#define WA_KLOAD(dst, t_) do { int kp_ = kb + 32 * WA_TT(t_) + r; kp_ = kp_ < 0 ? 0 : (kp_ >= U.nkeys ? U.nkeys - 1 : kp_); int ti_ = (kb >> 5) + WA_TT(t_); ti_ = ti_ < 0 ? 0 : (ti_ >= U.ntiles ? U.ntiles - 1 : ti_); \
            const bf16_t* kptr_ = TIL ? U.kt + (long)ti_ * (HD / 16) * 512 + lane * 8 : U.k + (long)kp_ * U.kstride + 8 * hh; \
            _Pragma("unroll") for (int s = 0; s < HD / 16; ++s) dst[s] = *(const bf16x8*)(kptr_ + (TIL ? 512 : 16) * s); } while (0)
        WA_KLOAD(kf, 0);
#pragma unroll
        for (int t = 0; t < TPC; ++t) {
            bf16x8 kn[HD / 16];
            if (t + 1 < TPC) WA_KLOAD(kn, t + 1);
            asm volatile("" ::: "memory");
#pragma unroll
            for (int i = 0; i < 16; ++i) S[t][i] = 0.f;
#pragma unroll
            for (int s = 0; s < HD / 16; ++s) S[t] = st16::mfma32(kf[s], qf[s], S[t]);
            if (t + 1 < TPC) {
#pragma unroll
                for (int s = 0; s < HD / 16; ++s) kf[s] = kn[s]; }
        }
#undef WA_KLOAD
        float cm = -1e30f;
#pragma unroll
        for (int t = 0; t < TPC; ++t) {
            const int p0 = kb + 32 * WA_TT(t), p1 = p0 + 31;
            const bool allv = WA_MASK_SKIP && (p0 >= 0) && (p1 < U.nkeys) && (!U.causal || p1 <= U.qpos0) && (U.qpos0 + 31 - p0 <= U.maxdist);
            if (allv) {
#pragma unroll
                for (int i = 0; i < 16; ++i) cm = fmaxf(cm, S[t][i]);
            } else {
#pragma unroll
                for (int i = 0; i < 16; ++i) { const int kp = p0 + kofs(i, hh);
                    const bool ok = (kp >= 0) && (kp < U.nkeys) && (!U.causal || kp <= qpos) && (qpos - kp <= U.maxdist);
                    const float sv = ok ? S[t][i] : -INFINITY; S[t][i] = sv; cm = fmaxf(cm, sv); }
            }
        }
        cm = fmaxf(cm, __shfl_xor(cm, 32));
        if (SINK && ch == 0) cm = fmaxf(cm, U.sink);
        const float mn = fmaxf(m, cm), alpha = __builtin_amdgcn_exp2f(m - mn);
        float ps = 0.f;
#pragma unroll
        for (int t = 0; t < TPC; ++t)
#pragma unroll
            for (int i = 0; i < 16; ++i) { const float p = __builtin_amdgcn_exp2f(S[t][i] - mn); S[t][i] = p; ps += p; }
        ps += __shfl_xor(ps, 32);
        if (SINK && ch == 0) ps += __builtin_amdgcn_exp2f(U.sink - mn);
        l = l * alpha + ps; m = mn;
        if (NCH > 1) {
#pragma unroll
            for (int dc = 0; dc < HD / 32; ++dc)
#pragma unroll
                for (int i = 0; i < 16; ++i) o[dc][i] *= alpha; }
        { if (!VPF) load_v<HD>(vr, U.v, U.vstride, kb + 32 * WA_TT(0), U.nkeys, lane);
          asm volatile("" : "+v"(S[0][0]) :: "memory");
#pragma unroll
          for (int t = 0; t < TPC; ++t) {
              VRegs<HD> vn; if (VPF && t + 1 < TPC) load_v<HD>(vn, U.v, U.vstride, kb + 32 * WA_TT(t + 1), U.nkeys, lane);
              write_v<HD>(vr, vl, lane); pv_tile<HD>(o, S[t], vl, lane);
              if (t + 1 < TPC) { if (VPF) vr = vn; else load_v<HD>(vr, U.v, U.vstride, kb + 32 * WA_TT(t + 1), U.nkeys, lane); } } }
    }
#undef WA_TT
    const float inv = 1.0f / l;
    if (WA_OLDS_SM) store_o_lds<HD>(o, inv, U.o, U.ostride, vl, lane); else store_o<HD>(o, inv, U.o + (long)r * U.ostride, hh);
    if (LSE) { if (hh == 0) U.lse[(long)r * U.lsestride] = (m + __builtin_amdgcn_logf(l)) * LN2; }
}

#ifndef SB_EARLY_EXIT
#define SB_EARLY_EXIT 1
#endif
constexpr float SB_EXIT_T = 110.0f;
template <int HD>
__device__ __forceinline__ void sb_unit(const bf16_t* qT, const bf16_t* kT, const bf16_t* v, bf16_t* o, long stride, int qpos0, WA_LAS unsigned char* vl, int lane) {
    const int r = lane & 31, hh = lane >> 5;
    bf16x8 qf[HD / 16];
    { const bf16_t* qp = qT + (long)(qpos0 >> 5) * (HD / 16) * 512 + lane * 8;
#pragma unroll
      for (int s = 0; s < HD / 16; ++s) qf[s] = *(const bf16x8*)(qp + 512 * s); }
    f32x16 oacc[HD / 32];
#pragma unroll
    for (int dc = 0; dc < HD / 32; ++dc)
#pragma unroll
        for (int i = 0; i < 16; ++i) oacc[dc][i] = 0.f;
    float carry = 1.f;
    const int qpos = qpos0 + r, ktd = qpos0 >> 5;
    bf16x8 kf[HD / 16];
    { const bf16_t* kptr = kT + (long)ktd * (HD / 16) * 512 + lane * 8;
#pragma unroll
      for (int s = 0; s < HD / 16; ++s) kf[s] = *(const bf16x8*)(kptr + 512 * s); }
    for (int kt = ktd; kt >= 0; --kt) {
        const int kn = kt > 0 ? kt - 1 : 0;
        VRegs<HD> vr; load_v<HD>(vr, v, stride, 32 * kt, 1 << 30, lane);
        bf16x8 kfn[HD / 16];
        { const bf16_t* kptr = kT + (long)kn * (HD / 16) * 512 + lane * 8;
#pragma unroll
          for (int s = 0; s < HD / 16; ++s) kfn[s] = *(const bf16x8*)(kptr + 512 * s); }
        asm volatile("" ::: "memory");
        f32x16 S;
#pragma unroll
        for (int i = 0; i < 16; ++i) S[i] = 0.f;
#pragma unroll
        for (int s = 0; s < HD / 16; ++s) S = st16::mfma32(kf[s], qf[s], S);
        const bool diag = (kt == ktd);
        float kp[16];
        f32x16 A;
#pragma unroll
        for (int i = 0; i < 16; ++i) { const float z = S[i]; const bool ok = !diag || (32 * kt + kofs(i, hh) < qpos);
            const float ez = __builtin_amdgcn_exp2f(-fabsf(z) * LOG2E), rc = __builtin_amdgcn_rcpf(1.0f + ez), er = ez * rc;
            const float sg = z >= 0.f ? rc : er, kk = z >= 0.f ? er : rc;
            A[i] = ok ? sg : 0.f; kp[i] = ok ? kk : 1.f; }
        float gs[4], pg[4];
#pragma unroll
        for (int g = 0; g < 4; ++g) { gs[g] = (kp[4 * g] * kp[4 * g + 1]) * (kp[4 * g + 2] * kp[4 * g + 3]); pg[g] = __shfl_xor(gs[g], 32); }
        float run = carry;
#pragma unroll
        for (int g = 3; g >= 0; --g) { const float T = run * (hh == 0 ? pg[g] : 1.f);
            const float t3 = T, t2 = t3 * kp[4 * g + 3], t1 = t2 * kp[4 * g + 2], t0 = t1 * kp[4 * g + 1];
            A[4 * g + 3] *= t3; A[4 * g + 2] *= t2; A[4 * g + 1] *= t1; A[4 * g] *= t0;
            run *= gs[g] * pg[g]; }
        carry = run;
        asm volatile("" : "+v"(A[0]), "+v"(A[15]) :: "memory");
        write_v<HD>(vr, vl, lane);
        pv_tile<HD>(oacc, A, vl, lane);
#if SB_EARLY_EXIT
        if (__all(carry == 0.f)) break;
#endif
#pragma unroll
        for (int s = 0; s < HD / 16; ++s) kf[s] = kfn[s];
    }
    if (WA_OLDS_SB) store_o_lds<HD>(oacc, 1.0f, o, stride, vl, lane); else store_o<HD>(oacc, 1.0f, o + (long)r * stride, hh);
}
}

constexpr int NWAVES = 8;
constexpr int BATCH = 4, SEQ = 4096, DM = 2048, DEPTH = 4, NMEM = 256, FF = 5632;
constexpr int MT = BATCH * SEQ;
constexpr int MMEM = BATCH * NMEM;
constexpr size_t MiB = 1u << 20;
constexpr size_t WS_CTL = 0;
constexpr size_t WS_SS = 1 * MiB;
constexpr size_t SS_BYTES = (size_t)MT * 8;
constexpr size_t ZERO_BYTES = 3328 * 1024;
constexpr size_t WS_W = 4 * MiB;
constexpr size_t WL_STRIDE = 168 * MiB, WL_GU1 = 0, WL_DN1 = 44 * MiB, WL_GU2 = 66 * MiB, WL_DN2 = 110 * MiB, WL_MQKV = 132 * MiB, WL_MO = 156 * MiB, WL_XQ = 164 * MiB, WL_XO = 166 * MiB;
constexpr size_t WS_WKV = WS_W + 4 * WL_STRIDE;
constexpr size_t WS_XB = WS_WKV + 16 * MiB;
constexpr size_t WS_MEMB = WS_XB + 64 * MiB;
constexpr size_t WS_ACT = WS_MEMB + 4 * MiB;
constexpr size_t WS_QKV = WS_ACT + 176 * MiB;
constexpr size_t WS_O = WS_QKV + 192 * MiB;
constexpr size_t WS_XQ = WS_O + 64 * MiB;
constexpr size_t WS_XO = WS_XQ + 16 * MiB;
constexpr size_t WS_KVM = WS_XO + 16 * MiB;
constexpr size_t WS_LSE = WS_KVM + 8 * MiB;
constexpr size_t WS_TABD = WS_LSE + 1 * MiB;
constexpr size_t WS_TABS = WS_TABD + 2 * MiB;
constexpr size_t WS_SSMEM = WS_TABS + 1 * MiB;
constexpr size_t WS_END = WS_SSMEM + 1 * MiB;
static_assert(WS_SS + 17 * SS_BYTES <= ZERO_BYTES && ZERO_BYTES <= WS_W, "zeroed region");
static_assert(WS_END < 1400ull * MiB, "workspace map must fit 4x the largest input tensor");
constexpr int CW_BAR = 4096;
constexpr int RING_OFF = 0, RING_BYTES = 131072;
constexpr int LDSCTL_OFF = 135168, MISC_OFF = LDSCTL_OFF + 320;
constexpr int LDS_BYTES = 147456;

#define GAS __attribute__((address_space(1)))
#define LAS __attribute__((address_space(3)))
typedef unsigned short bf16;
typedef unsigned v4u __attribute__((ext_vector_type(4)));
typedef unsigned v2u __attribute__((ext_vector_type(2)));
typedef float f32x4 __attribute__((ext_vector_type(4)));
#define LDS_WAIT() asm volatile("s_waitcnt lgkmcnt(0)" ::: "memory")
#define VM_WAIT() asm volatile("s_waitcnt vmcnt(0)" ::: "memory")
__device__ __forceinline__ unsigned pk2(float lo, float hi) { return pg8::cvt_pk_bf16(lo, hi); }
__device__ __forceinline__ float wave_sum(float v) {
#pragma unroll
    for (int o = 1; o < 64; o <<= 1) v += __shfl_xor(v, o);
    return v;
}
__device__ const float INVF_D[16] = {1.000000000e+00f, 4.403665960e-01f, 1.939227432e-01f, 8.539710194e-02f, 3.760603070e-02f, 1.656043902e-02f, 7.292664610e-03f, 3.211445874e-03f,
                                     1.414213562e-03f, 6.227723788e-04f, 2.742481884e-04f, 1.207697351e-04f, 5.318296098e-05f, 2.341999971e-05f, 1.031338616e-05f, 4.541670478e-06f};
__device__ const float INVF_S[8] = {1.000000000e+00f, 1.939227432e-01f, 3.760603070e-02f, 7.292664610e-03f, 1.414213562e-03f, 2.742481884e-04f, 5.318296098e-05f, 1.031338616e-05f};

#define XB_TMO      128
#define XB_XCNT(j)  (256  + 64 * (j))
#define XB_XSUB(j)  (1280 + 64 * (j))
#define XB_XGEN(j)  (2304 + 64 * (j))
#define XB_TOP      3328
#define XB_TOPGEN   3392
#define XCD_BAR_WORDS 3456
#define XB_SPIN_CAP (1u << 18)
#ifndef XB_FLAT_RELEASE
#define XB_FLAT_RELEASE 1
#endif

__device__ __forceinline__ unsigned xb_ld(unsigned* p)              { return __hip_atomic_load(p, __ATOMIC_RELAXED, __HIP_MEMORY_SCOPE_AGENT); }
__device__ __forceinline__ unsigned xb_add(unsigned* p, unsigned v) { return __hip_atomic_fetch_add(p, v, __ATOMIC_RELAXED, __HIP_MEMORY_SCOPE_AGENT); }
__device__ __forceinline__ unsigned xb_xcc_id() { return (unsigned)__builtin_amdgcn_s_getreg((3 << 11) | 20) & 0xFu; }
#define XB_SPIN(cond, bar) do { unsigned _sp = 0; while (cond) { __builtin_amdgcn_s_sleep(1); \
    if ((++_sp & 255u) == 0u) { if (xb_ld(&(bar)[XB_TMO])) break; if (_sp > XB_SPIN_CAP) { atomicAdd(&(bar)[XB_TMO], 1u); break; } } } } while (0)

struct XcdBarrier {
    unsigned* bar; unsigned x; unsigned ng;
    volatile LAS unsigned* st;
};

__device__ __forceinline__ XcdBarrier xcd_barrier_post(unsigned* bar, volatile LAS unsigned* st, const bool t0  ) {
    XcdBarrier b; b.bar = bar; b.x = xb_xcc_id(); b.st = st; b.ng = 0u;
    if (t0) (void)xb_add(&bar[XB_XCNT(b.x)], 1u);
    return b;
}
__device__ __forceinline__ void xcd_barrier_complete(unsigned* bar, unsigned x, unsigned& nloc, unsigned& nx, const unsigned G) {
    unsigned sum, cnt, mine, sp = 0u;
    for (;;) {
        sum = 0u; cnt = 0u; mine = 0u;
#pragma unroll
        for (unsigned j = 0; j < 16; ++j) { const unsigned c = xb_ld(&bar[XB_XCNT(j)]); sum += c; cnt += (c > 0u) ? 1u : 0u; mine = (j == x) ? c : mine; }
        if (sum == G) break;
        __builtin_amdgcn_s_sleep(1);
        if ((++sp & 255u) == 0u) { if (xb_ld(&bar[XB_TMO])) break; if (sp > XB_SPIN_CAP) { atomicAdd(&bar[XB_TMO], 1u); break; } }
    }
    nloc = mine > 0u ? mine : 1u; nx = cnt > 0u ? cnt : 1u;
}

__device__ __forceinline__ void xcd_barrier(const XcdBarrier& b, const bool t0) {
    asm volatile("s_waitcnt vmcnt(0)" ::: "memory");
    __syncthreads();
    if (t0) {
        unsigned* bar = b.bar;
        __builtin_amdgcn_s_waitcnt(0);
        unsigned nloc = b.st[0], nx = b.st[1];
        if (nloc == 0u) { xcd_barrier_complete(bar, b.x, nloc, nx, b.ng); b.st[0] = nloc; b.st[1] = nx; }
        const unsigned old = xb_add(&bar[XB_XSUB(b.x)], 1u);
        const unsigned gen = old / nloc;
        if (old + 1u == (gen + 1u) * nloc) {
            __builtin_amdgcn_fence(__ATOMIC_RELEASE, "agent");
            asm volatile("s_waitcnt vmcnt(0)" ::: "memory");
            const unsigned og = xb_add(&bar[XB_TOP], 1u);
            const unsigned tg = og / nx;
            if (og + 1u == (tg + 1u) * nx) xb_add(&bar[XB_TOPGEN], 1u);
            else XB_SPIN(xb_ld(&bar[XB_TOPGEN]) == tg, bar);
            __builtin_amdgcn_fence(__ATOMIC_ACQUIRE, "agent");
            if (!XB_FLAT_RELEASE) xb_add(&bar[XB_XGEN(b.x)], 1u);
            asm volatile("s_waitcnt vmcnt(0)" ::: "memory");
        } else {
            if (XB_FLAT_RELEASE) XB_SPIN(xb_ld(&bar[XB_TOPGEN]) == gen, bar);
            else XB_SPIN(xb_ld(&bar[XB_XGEN(b.x)]) == gen, bar);
            __builtin_amdgcn_fence(__ATOMIC_ACQUIRE, "agent");
            asm volatile("s_waitcnt vmcnt(0)" ::: "memory");
        }
    }
    __syncthreads();
}

__device__ __forceinline__ void conv_items(int& it, const int NGW, const float* W, const int K, const int N, const float* gain, const float scale, bf16* WT, const int mode, const int lane) {
    const int nblk = N >> 6, nitems = (K >> 6) * nblk, g = lane >> 4, j = lane & 15;
    while (it < nitems) {
        const int kb = it / nblk, nb = it - kb * nblk, k0 = kb << 6, n0 = nb << 6;
        const float* src = W + (size_t)(k0 + 16 * g) * N + n0 + 4 * j;
        f32x4 t[16];
#pragma unroll
        for (int i = 0; i < 16; ++i) t[i] = *(const f32x4*)(src + (size_t)i * N);
        f32x4 gv[4];
#pragma unroll
        for (int q = 0; q < 4; ++q) gv[q] = gain ? *(const f32x4*)(gain + k0 + 16 * g + 4 * q) * scale : (f32x4){scale, scale, scale, scale};
        int drow0 = n0; if (mode == 1) { const int hf = n0 >= FF ? 1 : 0; const int j0 = n0 - hf * FF; drow0 = (j0 >> 7) * 256 + hf * 128 + (j0 & 127); }
        if (mode >= 16) drow0 = (n0 < 512 ? 0 : 2048 - 512) + (mode - 16) * 512 + n0;
#pragma unroll
        for (int c = 0; c < 4; ++c) {
            v4u o0, o1;
            o0.x = pk2(t[0][c] * gv[0][0], t[1][c] * gv[0][1]); o0.y = pk2(t[2][c] * gv[0][2], t[3][c] * gv[0][3]); o0.z = pk2(t[4][c] * gv[1][0], t[5][c] * gv[1][1]); o0.w = pk2(t[6][c] * gv[1][2], t[7][c] * gv[1][3]);
            o1.x = pk2(t[8][c] * gv[2][0], t[9][c] * gv[2][1]); o1.y = pk2(t[10][c] * gv[2][2], t[11][c] * gv[2][3]); o1.z = pk2(t[12][c] * gv[3][0], t[13][c] * gv[3][1]); o1.w = pk2(t[14][c] * gv[3][2], t[15][c] * gv[3][3]);
            bf16* dst = WT + (size_t)(drow0 + 4 * j + c) * K + k0 + 16 * g;
            *(v4u*)dst = o0; *(v4u*)(dst + 8) = o1;
        }
        it += NGW;
    }
    it -= nitems;
}
__device__ __forceinline__ void row_to_bf16_ss(const float* xrow, bf16* orow, pg8::ssq_t* ssp, const int lane) {
    const f32x4* xr = (const f32x4*)xrow + lane; f32x4 v[8]; float s = 0.f;
#pragma unroll
    for (int j = 0; j < 8; ++j) { v[j] = xr[64 * j]; s += (v[j].x * v[j].x + v[j].y * v[j].y) + (v[j].z * v[j].z + v[j].w * v[j].w); }
    s = wave_sum(s);
    v2u* o8 = (v2u*)orow + lane;
#pragma unroll
    for (int j = 0; j < 8; ++j) { v2u w; w.x = pk2(v[j].x, v[j].y); w.y = pk2(v[j].z, v[j].w); o8[64 * j] = w; }
    if (lane == 0) *ssp = pg8::ssq_fix(s);
}

struct Args { const float* in[25]; float* out; unsigned char* ws; int lo, hi; };
constexpr int NPHASES = 43;
#ifndef MK_NG
#define MK_NG 1
#endif
constexpr int NG = MK_NG;

#ifndef MK_ONE_LAUNCH
#define MK_ONE_LAUNCH 1
#endif
#ifndef ATT_REP
#define ATT_REP 1
#endif
#ifndef DIL_XD
#define DIL_XD 1
#endif
#ifndef DIL_ROT
#define DIL_ROT 1
#endif
#ifndef BAR_REP
#define BAR_REP 1
#endif
#ifndef XA_TPC
#define XA_TPC 2
#endif
#ifndef SWA_TIL
#define SWA_TIL 1
#endif
#ifndef SWA_XD
#define SWA_XD 1
#endif
#ifndef PROBE_SAMEKV
#define PROBE_SAMEKV 0
#endif
#ifndef ATT_REP_KIND
#define ATT_REP_KIND -1
#endif
__global__ void __launch_bounds__(NWAVES * 64, 2) mk_fwd(Args args) {
    extern __shared__ __attribute__((aligned(16))) unsigned char lds_raw[];
    LAS unsigned char* lds = (LAS unsigned char*)lds_raw;
    volatile LAS unsigned* MISC = (volatile LAS unsigned*)(lds + MISC_OFF);
    const int wave = __builtin_amdgcn_readfirstlane((int)threadIdx.x >> 6);
#define LANE_ID(v) int v; asm volatile("v_mbcnt_lo_u32_b32 %0, -1, 0\n\tv_mbcnt_hi_u32_b32 %0, -1, %0" : "=v"(v))
    const int G = gridDim.x, bx = blockIdx.x;
    const int vcu = (G % 8 == 0) ? (bx % 8) * (G / 8) + bx / 8 : bx;
    const int gw = vcu * NWAVES + wave, NGW = G * NWAVES;
    const bool grp_ok = (G % (8 * NG) == 0) || NG == 1;
    const int ngr = grp_ok ? NG : 1, XPG = 8 / ngr;
    const int gidx = ngr == 1 ? 0 : (bx % 8) / XPG, lb = ngr == 1 ? bx : (bx / 8) * XPG + (bx % 8) % XPG, GL = G / ngr, nxl = ngr == 1 ? 8 : XPG;
    const int BG = BATCH / ngr, MG = MT / ngr, r0 = gidx * MG, MMG = MMEM / ngr, mr0 = gidx * MMG;
    const int lwv = lb * NWAVES + wave, NLW = GL * NWAVES;
    unsigned char* const ws = args.ws;
    { LANE_ID(l0); const int tid = wave * 64 + l0;
      for (int u = tid; u < (LDS_BYTES - LDSCTL_OFF) / 4; u += NWAVES * 64) ((LAS unsigned*)(lds + LDSCTL_OFF))[u] = 0u;
      __syncthreads();
      (void)xcd_barrier_post((unsigned*)(ws + WS_CTL) + CW_BAR + gidx * XCD_BAR_WORDS, MISC + 8, tid == 0);
      (void)xcd_barrier_post((unsigned*)(ws + WS_CTL) + CW_BAR + NG * XCD_BAR_WORDS, MISC + 12, tid == 0); }
    const int lo = args.lo, hi = args.hi;
    int ph = 0;
#define PH_IF if (ph >= lo && ph < hi)
#define PH_END do { if (ph >= lo && ph + 1 < hi) { XcdBarrier bar_; const bool glob_ = (ph == 0); \
        bar_.bar = (unsigned*)(ws + WS_CTL) + CW_BAR + (glob_ ? NG : gidx) * XCD_BAR_WORDS; bar_.x = xb_xcc_id(); bar_.st = MISC + (glob_ ? 12 : 8); bar_.ng = (unsigned)(glob_ ? G : GL); \
        LANE_ID(lb_); for (int br_ = 0; br_ < BAR_REP; ++br_) xcd_barrier(bar_, wave == 0 && lb_ == 0); } ++ph; } while (0)

#define xout (args.out)
#define xb ((bf16*)(ws + WS_XB))
#define memb ((bf16*)(ws + WS_MEMB))
#define act ((bf16*)(ws + WS_ACT))
#define qbuf ((bf16*)(ws + WS_QKV))
#define kbuf ((bf16*)(ws + WS_QKV + 64 * MiB))
#define vbuf ((bf16*)(ws + WS_QKV + 128 * MiB))
#define obuf ((bf16*)(ws + WS_O))
#define xqbuf ((bf16*)(ws + WS_XQ))
#define xobuf ((bf16*)(ws + WS_XO))
#define kvm ((bf16*)(ws + WS_KVM))
#define ssb ((pg8::ssq_t*)(ws + WS_SS))
#define ssmem ((pg8::ssq_t*)(ws + WS_SSMEM))
#define lseb ((float*)(ws + WS_LSE))
#define tabD ((float*)(ws + WS_TABD))
#define tabS ((float*)(ws + WS_TABS))
#define vl (lds + RING_OFF + wave * 10240)

    PH_IF {
        LANE_ID(lane); const int tid = wave * 64 + lane;
        int it = gw;
        for (int L = 0; L < DEPTH; ++L) {
            unsigned char* wl = ws + WS_W + (size_t)L * WL_STRIDE; const int kind = L % 3, j = L / 3;
            conv_items(it, NGW, args.in[4] + (size_t)L * DM * 2 * FF, DM, 2 * FF, args.in[3] + L * DM, 1.0f, (bf16*)(wl + WL_GU1), 1, lane);
            conv_items(it, NGW, args.in[5] + (size_t)L * FF * DM, FF, DM, nullptr, 0.5f, (bf16*)(wl + WL_DN1), 0, lane);
            conv_items(it, NGW, args.in[22] + (size_t)L * DM * 2 * FF, DM, 2 * FF, args.in[21] + L * DM, 1.0f, (bf16*)(wl + WL_GU2), 1, lane);
            conv_items(it, NGW, args.in[23] + (size_t)L * FF * DM, FF, DM, nullptr, 0.5f, (bf16*)(wl + WL_DN2), 0, lane);
            if (kind == 0) {
                conv_items(it, NGW, args.in[7] + (size_t)j * DM * 6144, DM, 6144, args.in[6] + L * DM, 1.0f, (bf16*)(wl + WL_MQKV), 0, lane);
                conv_items(it, NGW, args.in[8] + (size_t)j * 2048 * DM, 2048, DM, nullptr, 1.0f, (bf16*)(wl + WL_MO), 0, lane);
            } else if (kind == 1) {
                conv_items(it, NGW, args.in[9] + (size_t)j * DM * 4608, DM, 4608, args.in[6] + L * DM, 1.0f, (bf16*)(wl + WL_MQKV), 0, lane);
                conv_items(it, NGW, args.in[10] + (size_t)j * 1536 * DM, 1536, DM, nullptr, 1.0f, (bf16*)(wl + WL_MO), 0, lane);
            } else {
                conv_items(it, NGW, args.in[11] + (size_t)j * DM * 2560, DM, 2560, args.in[6] + L * DM, 1.0f, (bf16*)(wl + WL_MQKV), 0, lane);
                conv_items(it, NGW, args.in[14] + (size_t)j * 2048 * DM, 2048, DM, nullptr, 1.0f, (bf16*)(wl + WL_MO), 0, lane);
            }
            conv_items(it, NGW, args.in[18] + (size_t)L * DM * 512, DM, 512, args.in[16] + L * DM, 1.0f, (bf16*)(wl + WL_XQ), 0, lane);
            conv_items(it, NGW, args.in[19] + (size_t)L * DM * 1024, DM, 1024, args.in[17] + L * DM, 1.0f, (bf16*)(ws + WS_WKV), 16 + L, lane);
            conv_items(it, NGW, args.in[20] + (size_t)L * 512 * DM, 512, DM, nullptr, 1.0f, (bf16*)(wl + WL_XO), 0, lane);
        }
        for (int m = gw; m < MT; m += NGW) row_to_bf16_ss(args.in[0] + (size_t)m * DM, xb + (size_t)m * DM, ssb + m, lane);
        for (int m = gw; m < MMEM; m += NGW) row_to_bf16_ss(args.in[1] + (size_t)m * DM, memb + (size_t)m * DM, ssmem + m, lane);
        const int* pos = (const int*)args.in[2];
        for (int i = bx * (NWAVES * 64) + tid; i < MT * 16; i += G * NWAVES * 64) { const int t = i >> 4, f = i & 15; const float ang = (float)pos[t] * INVF_D[f];
            const double rev = (double)ang * 0.15915494309189535; const float fr = (float)(rev - floor(rev));
            tabD[2 * i] = __builtin_amdgcn_cosf(fr); tabD[2 * i + 1] = __builtin_amdgcn_sinf(fr); }
        for (int i = bx * (NWAVES * 64) + tid; i < MT * 8; i += G * NWAVES * 64) { const int t = i >> 3, f = i & 7; const float ang = (float)pos[t] * INVF_S[f];
            const double rev = (double)ang * 0.15915494309189535; const float fr = (float)(rev - floor(rev));
            tabS[2 * i] = __builtin_amdgcn_cosf(fr); tabS[2 * i + 1] = __builtin_amdgcn_sinf(fr); }
    }
    PH_END;


    for (int s = 0; s < 2 * DEPTH; ++s) {
        const int L = s >> 1, f = s & 1;
        unsigned char* const wl = ws + WS_W + (size_t)L * WL_STRIDE;
        PH_IF {
            pg8::Gemm g{xb + (size_t)r0 * DM, (const bf16*)(wl + (f ? WL_GU2 : WL_GU1)), MG, 2 * FF, DM}; pg8::GroupOrder S; S.init(MG, 2 * FF, GL, lb, nxl);
            pg8::EpiSwiGLU E{act, FF, ssb + (size_t)(4 * L + (f ? 3 : 0)) * MT, r0};
            pg8::gemm_phase<pg8::EpiSwiGLU, pg8::GroupOrder, true, true>(lds + RING_OFF, g, S, E, wave);
        }
        PH_END;
        PH_IF {
            pg8::Gemm g{act + (size_t)r0 * FF, (const bf16*)(wl + (f ? WL_DN2 : WL_DN1)), MG, DM, FF}; pg8::GroupOrder S; S.init(MG, DM, GL, lb, nxl, 4);
            pg8::EpiResid E{xb, ssb + (size_t)(4 * L + (f ? 4 : 1)) * MT, nullptr, r0};
            pg8::gemm_phase<pg8::EpiResid, pg8::GroupOrder, true, true>(lds + RING_OFF, g, S, E, wave);
        }
        PH_END;
        if (f) continue;
        const int kind = L % 3, jm = L / 3;
        PH_IF {
            const int N = kind == 0 ? 6144 : (kind == 1 ? 4608 : 2560);
            pg8::Gemm g{xb + (size_t)r0 * DM, (const bf16*)(wl + WL_MQKV), MG, N, DM}; pg8::GroupOrder S; S.init(MG, N, GL, lb, nxl);
            const pg8::EpiProj E{qbuf, (size_t)(32 * MiB), kind == 1 ? 1536 : 2048, kind == 0 ? 2048 : (kind == 1 ? 1536 : 256), kind == 1 ? 6 : 8, kind == 0 ? 16 : (kind == 1 ? 12 : 9),
                                 ssb + (size_t)(4 * L + 1) * MT, kind == 2 ? args.in[12] + jm * 2560 : nullptr,
                                 kind == 0 ? 0.08838834764831845f : (kind == 1 ? 0.08838834764831845f * 1.4426950408889634f : 0.125f * 1.4426950408889634f),
                                 kind == 0 ? 0 : (kind == 1 ? 128 : 64), kind == 1 ? (const float*)tabD : (const float*)tabS, r0, kind == 0 ? (3 | (4 << 4)) : (kind == 1 ? (3 | (4 << 4) | 256) : (SWA_TIL ? (3 | (4 << 4) | 512) : 0))};
            pg8::gemm_phase<pg8::EpiProj, pg8::GroupOrder, true, true>(lds + RING_OFF, g, S, E, wave);
        }
        PH_END;
        PH_IF for (int rep_ = 0; rep_ < ((ATT_REP_KIND < 0 || ATT_REP_KIND == kind) ? ATT_REP : 1); ++rep_) {
            LANE_ID(lane);
            if (kind == 0) {
                const bool xdeal = (NLW == 256 * nxl) && ((BG * 16) % (2 * nxl) == 0) && (BG * 2048 == 4 * NLW);
                for (int u = lwv; u < BG * 2048; u += NLW) {
                    const int jj = (u / NLW) & 3, wxl = ((lb / nxl) * NWAVES + wave) & 255;
                    const int c = xdeal ? (wxl & 127) : (u & 127), bhl = xdeal ? (lb % nxl) * (BG * 16 / nxl) + 2 * jj + (wxl >> 7) : (u >> 7), a = c & 31, quarter = ((c >> 5) + jj) & 3;
                    const int qb = quarter == 0 ? a : (quarter == 1 ? 63 - a : (quarter == 2 ? 64 + a : 127 - a));
                    const int b = gidx * BG + (bhl >> 4), h = bhl & 15; const size_t base = (size_t)b * SEQ * 2048 + h * 128;
#ifndef MK_NO_SB
                    wa::sb_unit<128>(qbuf + (size_t)(b * 16 + h) * 524288, kbuf + (size_t)(PROBE_SAMEKV && rep_ + 1 < ATT_REP ? 0 : b * 16 + h) * 524288, vbuf + (PROBE_SAMEKV && rep_ + 1 < ATT_REP ? 0 : base), obuf + base + (size_t)(32 * qb) * 2048, 2048, 32 * qb, vl, lane);
#endif
                }
            } else if (kind == 1) {
                const int wpxd = GL / nxl; const bool xd1 = DIL_XD && (GL % nxl == 0) && (wpxd % 16 == 0) && ((BG * 12) % (nxl * (wpxd / 16)) == 0) && (NWAVES == 8);
                for (int u = lwv, kx = 0; u < BG * 1536; u += NLW, ++kx) {
                    const int ppr = wpxd / 16  , jx = lb / nxl;
                    const int idx = xd1 ? (jx & 15) * 8 + wave : (u & 127), hb = xd1 ? ((lb % nxl) * (BG * 12 / nxl) + kx * ppr + (jx >> 4)) : (u >> 7), head = hb % 12, b = gidx * BG + hb / 12, g2 = 2 * (head >> 2), dil = 1 << g2;
                    const int p = idx >> (7 - g2), qb = idx & ((128 >> g2) - 1);
                    const size_t row0 = (size_t)b * SEQ + p; const size_t qrow = row0 + (size_t)(32 * qb) * dil;
                    wa::SmUnit U; U.q = qbuf + qrow * 1536 + head * 128; U.k = kbuf + row0 * 1536 + head * 128; U.v = vbuf + row0 * 1536 + head * 128; U.o = obuf + qrow * 1536 + head * 128;
                    U.qstride = U.kstride = U.vstride = U.ostride = (long)dil * 1536; U.qpos0 = 32 * qb; U.kpos0 = 32 * qb - 128; U.nkeys = SEQ >> g2; U.maxdist = 128; U.causal = 1; U.sink = 0.f;
                    U.lse = lseb + qrow * 12 + head; U.lsestride = (long)dil * 12;
                    U.ntiles = 128 >> g2; U.kt = kbuf + ((size_t)(b * 12 + head) * 128 + (size_t)p * (128 >> g2)) * 4096; U.qt = qbuf + ((size_t)(b * 12 + head) * 128 + (size_t)p * (128 >> g2) + qb) * 4096;
#ifndef MK_NO_DIL
                    wa::sm_unit<128, 5, 1, false, true, true, DIL_ROT != 0>(U, vl, lane);
#endif
                }
            } else {
                const float* sinks = args.in[13] + jm * 32;
                const int wpx = GL / nxl; const bool xd2 = SWA_XD && (GL % nxl == 0) && (128 % wpx == 0) && ((BG * 4) % nxl == 0) && (NWAVES == 8);
                for (int u = lwv, kx = 0; u < BG * 4096; u += NLW, ++kx) {
                    const int ppp = 128 / wpx, pr = (lb % nxl) * (BG * 4 / nxl) + kx / ppp;
                    const int hq = u & 7, qb = xd2 ? (kx % ppp) * wpx + lb / nxl : (u >> 3) & 127, kvh = xd2 ? (pr & 3) : (u >> 10) & 3, b = gidx * BG + (xd2 ? (pr >> 2) : (u >> 12)), head = kvh * 8 + hq;
                    const size_t row0 = (size_t)b * SEQ, qrow = row0 + 32 * qb;
                    wa::SmUnit U; U.q = qbuf + qrow * 2048 + head * 64; U.k = kbuf + row0 * 256 + kvh * 64; U.v = vbuf + row0 * 256 + kvh * 64; U.o = obuf + qrow * 2048 + head * 64;
                    U.qstride = 2048; U.kstride = 256; U.vstride = 256; U.ostride = 2048; U.qpos0 = 32 * qb; U.kpos0 = 32 * qb - 128; U.nkeys = SEQ; U.maxdist = 127; U.causal = 1;
                    U.sink = sinks[head] * 1.4426950408889634f; U.lse = nullptr; U.lsestride = 0; U.qt = qbuf + ((size_t)(b * 32 + head) * 128 + qb) * 2048; U.kt = kbuf + (size_t)(b * 4 + kvh) * 128 * 2048; U.ntiles = 128;
#ifndef MK_NO_SWA
                    wa::sm_unit<64, 5, 1, true, false, SWA_TIL != 0>(U, vl, lane);
#endif
                }
            }
        }
        PH_END;
        if (kind == 1) {
            PH_IF {
                LANE_ID(lane); const int tid = wave * 64 + lane;
                for (int il = lb * (NWAVES * 64) + tid; il < MG * 192; il += GL * NWAVES * 64) { const int i = r0 * 192 + il; const int row = i / 192, c8 = i - row * 192, head = c8 >> 4, g = head >> 2, jj = head & 3;
                    const float l0 = lseb[row * 12 + jj], l1 = lseb[row * 12 + 4 + jj], l2 = lseb[row * 12 + 8 + jj]; const float mx = fmaxf(l0, fmaxf(l1, l2));
                    const float e0 = __expf(l0 - mx), e1 = __expf(l1 - mx), e2 = __expf(l2 - mx); const float al = (g == 0 ? e0 : (g == 1 ? e1 : e2)) / (e0 + e1 + e2);
                    v4u w = *(v4u*)(obuf + (size_t)i * 8); v4u o;
#define SC2(x) pk2(st16::lo(x) * al, st16::hi(x) * al)
                    o.x = SC2(w.x); o.y = SC2(w.y); o.z = SC2(w.z); o.w = SC2(w.w);
#undef SC2
                    *(v4u*)(obuf + (size_t)i * 8) = o; }
            }
            PH_END;
        }
        PH_IF {
            const int Ko = kind == 1 ? 1536 : 2048;
            pg8::Gemm g{obuf + (size_t)r0 * Ko, (const bf16*)(wl + WL_MO), MG, DM, Ko}; pg8::GroupOrder S; S.init(MG, DM, GL, lb, nxl, 4);
            pg8::EpiResid E{xb, ssb + (size_t)(4 * L + 2) * MT, kind == 2 ? args.in[15] + jm * DM : nullptr, r0};
            pg8::gemm_phase<pg8::EpiResid, pg8::GroupOrder, true, true>(lds + RING_OFF, g, S, E, wave);
        }
        PH_END;
        PH_IF {
            if (L == 0 && lb >= GL / 2) {
                pg8::Gemm g{memb + (size_t)mr0 * DM, (const bf16*)(ws + WS_WKV), MMG, 4096, DM}; pg8::GroupOrder S; S.init(MMG, 4096, GL / 2, lb - GL / 2, nxl);
                const pg8::EpiProj E{kvm, (size_t)MMEM * 2048, 2048, 2048, 8, 1 << 30, ssmem, nullptr, 1.0f, 0, nullptr, mr0, 1};
                pg8::gemm_phase<pg8::EpiProj, pg8::GroupOrder, true, true>(lds + RING_OFF, g, S, E, wave);
            }
            pg8::Gemm g{xb + (size_t)r0 * DM, (const bf16*)(wl + WL_XQ), MG, 512, DM}; pg8::GroupOrder S; S.init(MG, 512, GL, lb, nxl);
            const pg8::EpiProj E{xqbuf, 0, 512, 512, 1 << 30, 1 << 30, ssb + (size_t)(4 * L + 2) * MT, nullptr, 0.08838834764831845f * 1.4426950408889634f, 0, nullptr, r0, 1 | (4 << 4)};
            pg8::gemm_phase<pg8::EpiProj, pg8::GroupOrder, true, true>(lds + RING_OFF, g, S, E, wave);
        }
        PH_END;
        PH_IF for (int rep_ = 0; rep_ < ((ATT_REP_KIND < 0 || ATT_REP_KIND == 3) ? ATT_REP : 1); ++rep_) {
            LANE_ID(lane);
            for (int u = lwv; u < BG * 512; u += NLW) {
                const int qb = u & 127, h = (u >> 7) & 3, b = gidx * BG + (u >> 9); const size_t qrow = (size_t)b * SEQ + 32 * qb;
                wa::SmUnit U; U.q = nullptr; U.k = nullptr; U.v = kvm + (size_t)MMEM * 2048 + (size_t)b * NMEM * 2048 + L * 512 + h * 128; U.o = xobuf + qrow * 512 + h * 128;
                U.qt = xqbuf + ((size_t)(b * 4 + h) * 128 + qb) * 4096; U.kt = kvm + (size_t)(b * 16 + L * 4 + h) * 8 * 4096; U.ntiles = 8;
                U.qstride = 512; U.kstride = 2048; U.vstride = 2048; U.ostride = 512; U.qpos0 = 32 * qb; U.kpos0 = 0; U.nkeys = NMEM; U.maxdist = 1 << 30; U.causal = 0; U.sink = 0.f; U.lse = nullptr; U.lsestride = 0;
#ifndef MK_NO_XA
                wa::sm_unit<128, XA_TPC, 8 / XA_TPC, false, false, true>(U, vl, lane);
#endif
            }
        }
        PH_END;
        PH_IF {
            pg8::Gemm g{xobuf + (size_t)r0 * 512, (const bf16*)(wl + WL_XO), MG, DM, 512}; pg8::GroupOrder S; S.init(MG, DM, GL, lb, nxl, 4);
            pg8::EpiResid E{xb, ssb + (size_t)(4 * L + 3) * MT, nullptr, r0};
            pg8::gemm_phase<pg8::EpiResid, pg8::GroupOrder, true, true>(lds + RING_OFF, g, S, E, wave);
        }
        PH_END;
    }
    PH_IF {
        LANE_ID(lane);
        const pg8::ssq_t* ssf = ssb + (size_t)16 * MT; const f32x4* gn = (const f32x4*)args.in[24] + lane;
        for (int m = r0 + lwv; m < r0 + MG; m += NLW) { const float ri = pg8::rinv_of(ssf, m); f32x4* xr = (f32x4*)(xout + (size_t)m * DM) + lane; const v2u* xi = (const v2u*)(xb + (size_t)m * DM) + lane;
#pragma unroll
            for (int j = 0; j < 8; ++j) { const v2u w = xi[64 * j]; const f32x4 gg = gn[64 * j];
                f32x4 v; v[0] = st16::lo(w.x); v[1] = st16::hi(w.x); v[2] = st16::lo(w.y); v[3] = st16::hi(w.y);
                xr[64 * j] = v * ri * gg; } }
    }
    PH_END;
#undef PH_IF
#undef PH_END
}

extern "C" void kernel_launch(void* const* d_in, const int* in_sizes, int n_in, void* d_out, int out_size, void* d_ws, size_t ws_size, hipStream_t stream) {
    static int grid = 0;
    if (grid == 0) {
        if (n_in != 25 || out_size != MT * DM || ws_size < WS_END) { fprintf(stderr, "kernel_launch: unexpected shapes (n_in %d, out %d, ws %zu < %zu); nothing launched\n", n_in, out_size, ws_size, (size_t)WS_END); grid = -1; return; }
        int dev = 0, cus = 0, per_cu = 0;
        if (hipGetDevice(&dev) != hipSuccess || hipDeviceGetAttribute(&cus, hipDeviceAttributeMultiprocessorCount, dev) != hipSuccess) { fprintf(stderr, "kernel_launch: device query failed\n"); grid = -1; return; }
        if (hipFuncSetAttribute((const void*)mk_fwd, hipFuncAttributeMaxDynamicSharedMemorySize, LDS_BYTES) != hipSuccess) { fprintf(stderr, "kernel_launch: hipFuncSetAttribute failed\n"); grid = -1; return; }
        if (hipOccupancyMaxActiveBlocksPerMultiprocessor(&per_cu, (const void*)mk_fwd, NWAVES * 64, LDS_BYTES) != hipSuccess || per_cu < 1)
            fprintf(stderr, "kernel_launch: note: occupancy query reports %d workgroups per CU\n", per_cu);
        (void)hipGetLastError();
        grid = cus;
    }
    if (grid < 0) return;
    if (hipMemsetAsync((char*)d_ws + WS_CTL, 0, ZERO_BYTES, stream) != hipSuccess) { fprintf(stderr, "kernel_launch: memset failed\n"); return; }
    Args a{};
    for (int i = 0; i < 25; ++i) a.in[i] = (const float*)d_in[i];
    a.out = (float*)d_out; a.ws = (unsigned char*)d_ws;
#if MK_ONE_LAUNCH
    a.lo = 0; a.hi = NPHASES;
    hipLaunchKernelGGL(mk_fwd, dim3(grid), dim3(NWAVES * 64), LDS_BYTES, stream, a);
#else
    for (int p = 0; p < NPHASES; ++p) { a.lo = p; a.hi = p + 1; hipLaunchKernelGGL(mk_fwd, dim3(grid), dim3(NWAVES * 64), LDS_BYTES, stream, a); }
#endif
    const hipError_t le = hipPeekAtLastError();
    if (le != hipSuccess) fprintf(stderr, "kernel_launch: launch failed: %s\n", hipGetErrorName(le));
}
```

```cpp
#include <hip/hip_runtime.h>
#include <cstdio>
#include <cstdint>
#include <cmath>
#ifndef MK_F16
#define MK_F16 0
#endif
namespace st16 {
typedef short s16x8 __attribute__((ext_vector_type(8)));
typedef float v4f __attribute__((ext_vector_type(4)));
typedef float v16f __attribute__((ext_vector_type(16)));
#if MK_F16
typedef _Float16 h16x8 __attribute__((ext_vector_type(8)));
typedef _Float16 h16x2 __attribute__((ext_vector_type(2)));
typedef float v2f __attribute__((ext_vector_type(2)));
__device__ __forceinline__ unsigned pack(float lo, float hi) { unsigned r; asm volatile("v_cvt_pk_f16_f32 %0, %1, %2" : "=v"(r) : "v"(lo), "v"(hi)); return r; }
__device__ __forceinline__ float lo(unsigned w) { return (float)__builtin_bit_cast(h16x2, w)[0]; }
__device__ __forceinline__ float hi(unsigned w) { return (float)__builtin_bit_cast(h16x2, w)[1]; }
__device__ __forceinline__ v4f mfma16(s16x8 a, s16x8 b, v4f c) { return __builtin_amdgcn_mfma_f32_16x16x32_f16(__builtin_bit_cast(h16x8, a), __builtin_bit_cast(h16x8, b), c, 0, 0, 0); }
__device__ __forceinline__ v16f mfma32(s16x8 a, s16x8 b, v16f c) { return __builtin_amdgcn_mfma_f32_32x32x16_f16(__builtin_bit_cast(h16x8, a), __builtin_bit_cast(h16x8, b), c, 0, 0, 0); }
#else
__device__ __forceinline__ unsigned pack(float lo, float hi) { unsigned r; asm volatile("v_cvt_pk_bf16_f32 %0, %1, %2" : "=v"(r) : "v"(lo), "v"(hi)); return r; }
__device__ __forceinline__ float lo(unsigned w) { return __uint_as_float(w << 16); }
__device__ __forceinline__ float hi(unsigned w) { return __uint_as_float(w & 0xffff0000u); }
__device__ __forceinline__ v4f mfma16(s16x8 a, s16x8 b, v4f c) { return __builtin_amdgcn_mfma_f32_16x16x32_bf16(a, b, c, 0, 0, 0); }
__device__ __forceinline__ v16f mfma32(s16x8 a, s16x8 b, v16f c) { return __builtin_amdgcn_mfma_f32_32x32x16_bf16(a, b, c, 0, 0, 0); }
#endif
}

namespace pg8 {
#define PG8_LAS __attribute__((address_space(3)))
typedef unsigned short bf16_t;
typedef short bf16x8 __attribute__((ext_vector_type(8)));
typedef float f32x4 __attribute__((ext_vector_type(4)));
typedef unsigned u32x4 __attribute__((ext_vector_type(4)));
constexpr int BM = 256, BK = 64, HALF = 128, HTB = HALF * BK * 2  , STAGE_BYTES = 8 * HTB, NXCD = 8, WGM = 8;

__host__ __device__ __forceinline__ int lds_byte(int r, int c) { const int st = (r >> 4) * 2 + (c >> 5), rr = r & 15, cc = c & 31, ob = rr * 64 + cc * 2; return st * 1024 + (ob ^ (((ob >> 9) & 1) << 5)); }
__host__ __device__ __forceinline__ void stage_rc(int b, int& R, int& C) { const int st = b / 1024, sb = b % 1024, swz = sb ^ (((sb >> 9) & 1) << 5); R = (st >> 1) * 16 + swz / 64; C = (st & 1) * 32 + (swz % 64) / 2; }
__host__ __device__ __forceinline__ int perm32(int rho) { const int n = rho >> 4, i = rho & 15; return 8 * (i >> 2) + 4 * n + (i & 3); }

struct Unit { int pm, pn; };
struct Gemm { const bf16_t* A; const bf16_t* Bt; int M, N, K; };

struct StaticOrder {
    int nM, nN, nwg, G, c;
    __host__ __device__ void init(int M, int N, int G_, int c_) { nM = M / BM; nN = N / BM; nwg = nM * nN; G = G_; c = c_; }
    __host__ __device__ bool next(int i, Unit& u) const {
        const long L = (long)i * G + c; if (L >= nwg) return false;
        int wgid = (int)L; { const int q = nwg / NXCD, r = nwg % NXCD, xcd = wgid % NXCD, off = wgid / NXCD; wgid = (xcd < r ? xcd * (q + 1) : r * (q + 1) + (xcd - r) * q) + off; }
        const int nig = WGM * nN, gid = wgid / nig, fm = gid * WGM, gsz = (nM - fm) < WGM ? (nM - fm) : WGM;
        u.pm = fm + ((wgid % nig) % gsz); u.pn = (wgid % nig) / gsz; return true;
    }
    __device__ __forceinline__ void a_ready(const Unit&) const {}
    __device__ __forceinline__ void done(const Unit&) const {}
};
struct GroupOrder {
    int nM, nN, nwg, G, c, nx, wgm;
    __host__ __device__ void init(int M, int N, int G_, int c_, int nx_, int wgm_ = WGM) { nM = M / BM; nN = N / BM; nwg = nM * nN; G = G_; c = c_; nx = nx_; wgm = wgm_; }
    __host__ __device__ bool next(int i, Unit& u) const {
        const long L = (long)i * G + c; if (L >= nwg) return false;
        int wgid = (int)L; { const int q = nwg / nx, r = nwg % nx, xcd = wgid % nx, off = wgid / nx; wgid = (xcd < r ? xcd * (q + 1) : r * (q + 1) + (xcd - r) * q) + off; }
        const int nig = wgm * nN, gid = wgid / nig, fm = gid * wgm, gsz = (nM - fm) < wgm ? (nM - fm) : wgm;
        u.pm = fm + ((wgid % nig) % gsz); u.pn = (wgid % nig) / gsz; return true;
    }
    __device__ __forceinline__ void a_ready(const Unit&) const {}
    __device__ __forceinline__ void done(const Unit&) const {}
};

__device__ __forceinline__ unsigned cvt_pk_bf16(float lo, float hi) { return st16::pack(lo, hi); }
typedef float f32x2 __attribute__((ext_vector_type(2)));
constexpr float RMS_EPS = 1e-6f, INV_D = 1.0f / 2048.0f, LOG2E = 1.4426950408889634f;
typedef unsigned long long ssq_t;
constexpr float SSQ_SCALE = 16777216.0f;
__device__ __forceinline__ ssq_t ssq_fix(float s) { return (ssq_t)(s * SSQ_SCALE + 0.5f); }
__device__ __forceinline__ float rinv_from(ssq_t s) { const float sf = (float)(unsigned)(s >> 32) * 4294967296.0f + (float)(unsigned)s; return __builtin_amdgcn_rsqf(sf * (INV_D / SSQ_SCALE) + RMS_EPS); }
__device__ __forceinline__ float rinv_of(const ssq_t* ss, int row) { const ssq_t s = ss[row]; const float sf = (float)(unsigned)(s >> 32) * 4294967296.0f + (float)(unsigned)s;
    return __builtin_amdgcn_rsqf(sf * (INV_D / SSQ_SCALE) + RMS_EPS); }

struct PreRinv { float ri[8]; };
struct PreNone {};
#ifndef EPI_REP
#define EPI_REP 1
#endif
struct EpiSwiGLU {
    static constexpr bool PERM = true, AFTER_DRAIN = false; static constexpr int REP = EPI_REP;
    bf16_t* O; int ldc; const ssq_t* ss; int roff;
    typedef PreNone Pre;
    __device__ __forceinline__ void prefetch(Pre&, const Unit&, int, int, int, int) const {}
    struct Nx { ssq_t a, b; };
    __device__ __forceinline__ void nx_issue(Nx& x, const Unit& u, int wr, int lane) const { const ssq_t* p = ss + roff + u.pm * BM + wr * 64 + lane; x.a = p[0]; x.b = p[HALF]; }
    __device__ __forceinline__ void nx_commit(const Nx& x, PG8_LAS float* slot, int lane) const { slot[lane] = rinv_from(x.a); slot[64 + lane] = rinv_from(x.b); }
    __device__ __forceinline__ void operator()(const f32x4 (&acc)[2][2][4][2], const Unit& u, int wr, int wc, int fr, int fq, const Pre&, const PG8_LAS float* slot) const {
        const int row0 = roff + u.pm * BM + wr * 64 + fr, col0 = u.pn * HALF + wc * 32 + 8 * fq;
#pragma unroll
        for (int ai = 0; ai < 2; ++ai)
#pragma unroll
            for (int m = 0; m < 4; ++m) { const int r = row0 + ai * HALF + m * 16; const float ri = slot[ai * 64 + m * 16 + fr], rl = ri * (-LOG2E), rq = ri * ri;
                float h[8];
#pragma unroll
                for (int n = 0; n < 2; ++n)
#pragma unroll
                    for (int j = 0; j < 4; j += 2) {
                        const f32x2 g = (f32x2){acc[ai][0][m][n][j], acc[ai][0][m][n][j + 1]}, uu = (f32x2){acc[ai][1][m][n][j], acc[ai][1][m][n][j + 1]};
                        const f32x2 t = g * rl; f32x2 e; e.x = __builtin_amdgcn_exp2f(t.x); e.y = __builtin_amdgcn_exp2f(t.y);
                        const f32x2 d = e + 1.0f; f32x2 rc; rc.x = __builtin_amdgcn_rcpf(d.x); rc.y = __builtin_amdgcn_rcpf(d.y);
                        const f32x2 hv = (g * uu) * (rc * rq); h[4 * n + j] = hv.x; h[4 * n + j + 1] = hv.y; }
                u32x4 w; w.x = cvt_pk_bf16(h[0], h[1]); w.y = cvt_pk_bf16(h[2], h[3]); w.z = cvt_pk_bf16(h[4], h[5]); w.w = cvt_pk_bf16(h[6], h[7]);
                *(u32x4*)(O + (size_t)r * ldc + col0) = w; }
    }
};

struct EpiResid {
    static constexpr bool PERM = true, AFTER_DRAIN = false; static constexpr int REP = 1;
    bf16_t* xb; ssq_t* ssn; const float* bias; int roff;
    typedef PreNone Pre;
    __device__ __forceinline__ void prefetch(Pre&, const Unit&, int, int, int, int) const {}
    struct Nx {};
    __device__ __forceinline__ void nx_issue(Nx&, const Unit&, int, int) const {}
    __device__ __forceinline__ void nx_commit(const Nx&, PG8_LAS float*, int) const {}
    __device__ __forceinline__ void operator()(const f32x4 (&acc)[2][2][4][2], const Unit& u, int wr, int wc, int fr, int fq, const Pre&, const PG8_LAS float*) const {
        const int row0 = roff + u.pm * BM + wr * 64 + fr, col0 = u.pn * BM + wc * 32 + 8 * fq;
        f32x4 bv[2][2];
#pragma unroll
        for (int bj = 0; bj < 2; ++bj)
#pragma unroll
            for (int n = 0; n < 2; ++n) bv[bj][n] = bias ? *(const f32x4*)(bias + col0 + bj * HALF + 4 * n) : (f32x4){0.f, 0.f, 0.f, 0.f};
#pragma unroll
        for (int ai = 0; ai < 2; ++ai) {
            u32x4 X[4][2];
#pragma unroll
            for (int m = 0; m < 4; ++m)
#pragma unroll
                for (int bj = 0; bj < 2; ++bj) X[m][bj] = *(const u32x4*)(xb + (size_t)(row0 + ai * HALF + m * 16) * 2048 + col0 + bj * HALF);
            asm volatile("" : "+v"(X[0][0]), "+v"(X[0][1]), "+v"(X[1][0]), "+v"(X[1][1]), "+v"(X[2][0]), "+v"(X[2][1]), "+v"(X[3][0]), "+v"(X[3][1]) :: "memory");
#pragma unroll
            for (int m = 0; m < 4; ++m) { const int r = row0 + ai * HALF + m * 16; float sq = 0.f;
#pragma unroll
                for (int bj = 0; bj < 2; ++bj) { bf16_t* p = xb + (size_t)r * 2048 + col0 + bj * HALF;
                    const u32x4 xo = X[m][bj];
                    f32x4 v0, v1;
                    v0[0] = st16::lo(xo.x); v0[1] = st16::hi(xo.x); v0[2] = st16::lo(xo.y); v0[3] = st16::hi(xo.y);
                    v1[0] = st16::lo(xo.z); v1[1] = st16::hi(xo.z); v1[2] = st16::lo(xo.w); v1[3] = st16::hi(xo.w);
                    v0 = v0 + acc[ai][bj][m][0] + bv[bj][0]; v1 = v1 + acc[ai][bj][m][1] + bv[bj][1];
                    u32x4 w; w.x = cvt_pk_bf16(v0[0], v0[1]); w.y = cvt_pk_bf16(v0[2], v0[3]); w.z = cvt_pk_bf16(v1[0], v1[1]); w.w = cvt_pk_bf16(v1[2], v1[3]);
                    *(u32x4*)p = w;
                    sq += (v0[0] * v0[0] + v0[1] * v0[1]) + (v0[2] * v0[2] + v0[3] * v0[3]) + (v1[0] * v1[0] + v1[1] * v1[1]) + (v1[2] * v1[2] + v1[3] * v1[3]); }
                sq += __shfl_xor(sq, 16); sq += __shfl_xor(sq, 32);
                if (fq == 0) atomicAdd(ssn + r, ssq_fix(sq)); } }
    }
};

struct EpiProj {
    static constexpr bool PERM = true, AFTER_DRAIN = false; static constexpr int REP = 1;
    bf16_t* d0; size_t tstride; int ld0, ld12, t1, t2; const ssq_t* ss; const float* bias; float qscale; int hd; const float* rtab; int roff; int tl;
    typedef PreNone Pre;
    __device__ __forceinline__ void prefetch(Pre&, const Unit&, int, int, int, int) const {}
    struct Nx { ssq_t a, b; };
    __device__ __forceinline__ void nx_issue(Nx& x, const Unit& u, int wr, int lane) const { const ssq_t* p = ss + roff + u.pm * BM + wr * 64 + lane; x.a = p[0]; x.b = p[HALF]; }
    __device__ __forceinline__ void nx_commit(const Nx& x, PG8_LAS float* slot, int lane) const { slot[lane] = rinv_from(x.a); slot[64 + lane] = rinv_from(x.b); }
    __device__ __forceinline__ void operator()(const f32x4 (&acc)[2][2][4][2], const Unit& u, int wr, int wc, int fr, int fq, const Pre&, const PG8_LAS float* slot) const {
        const int pn = u.pn; const int tsel = pn >= t2 ? 2 : (pn >= t1 ? 1 : 0);
        bf16_t* base = d0 + (size_t)tsel * tstride; const int ld = tsel == 0 ? ld0 : ld12; const int tf = pn >= t2 ? t2 : (pn >= t1 ? t1 : 0);
        const float sc = tsel == 0 ? qscale : 1.0f;
        const int row0 = roff + u.pm * BM + wr * 64 + fr, col0 = (pn - tf) * BM + wc * 32 + 8 * fq, gcol0 = pn * BM + wc * 32 + 8 * fq;
        const bool rotw = (hd != 0) && (tsel < 2) && (hd == 128 ? (wc == 0) : ((wc & 1) == 0));
        const bool rotl = (hd == 128) ? true : (fq < 2);
        const int half = hd >> 3, xr = hd >> 2;
        const int ii0 = (hd == 128) ? 8 * (fq & 1) : 0;
        const float sgn = ((hd == 128) ? (fq < 2) : (fq == 0)) ? -1.0f : 1.0f;
#pragma unroll
        for (int ai = 0; ai < 2; ++ai)
#pragma unroll
            for (int m = 0; m < 4; ++m) { const int r = row0 + ai * HALF + m * 16; const float ri = slot[ai * 64 + m * 16 + fr];
                f32x4 cs[4];
                if (rotw) { const f32x4* tp = (const f32x4*)(rtab + ((size_t)r * half + ii0) * 2);
#pragma unroll
                    for (int q = 0; q < 4; ++q) cs[q] = tp[q]; }
#pragma unroll
                for (int bj = 0; bj < 2; ++bj) { float v[8];
                    f32x4 b0 = (f32x4){0.f, 0.f, 0.f, 0.f}, b1 = b0;
                    if (bias) { b0 = *(const f32x4*)(bias + gcol0 + bj * HALF); b1 = *(const f32x4*)(bias + gcol0 + bj * HALF + 4); }
#pragma unroll
                    for (int j = 0; j < 4; ++j) { v[j] = acc[ai][bj][m][0][j] * ri + b0[j]; v[4 + j] = acc[ai][bj][m][1][j] * ri + b1[j]; }
                    if (rotw) {
#pragma unroll
                        for (int i = 0; i < 8; ++i) { const float o = __shfl_xor(v[i], xr); const float c = cs[i >> 1][2 * (i & 1)], s = cs[i >> 1][2 * (i & 1) + 1];
                            const float nv = v[i] * c + sgn * o * s; v[i] = rotl ? nv : v[i]; } }
                    u32x4 w; w.x = cvt_pk_bf16(v[0] * sc, v[1] * sc); w.y = cvt_pk_bf16(v[2] * sc, v[3] * sc); w.z = cvt_pk_bf16(v[4] * sc, v[5] * sc); w.w = cvt_pk_bf16(v[6] * sc, v[7] * sc);
                    const int cq = col0 + bj * HALF;
                    unsigned off = (unsigned)r * (unsigned)ld + (unsigned)cq;
                    if ((tl >> tsel) & 1) {
                        const int hdl = (tl & 512) ? 6 : 7;
                        const int lsq = 8 + ((tl >> 4) & 15), H = ld >> hdl, head = __builtin_amdgcn_readfirstlane(cq >> hdl), cc = cq & ((1 << hdl) - 1);
                        const int l2d = (tl & 256) ? 2 * (head >> 2) : 0;
                        const unsigned b = (unsigned)r >> lsq, pos = (unsigned)r & ((1u << lsq) - 1u), a = pos >> l2d, p = pos & ((1u << l2d) - 1u), ft = (p << (lsq - l2d - 5)) + (a >> 5);
                        off = ((((b * (unsigned)H + (unsigned)head) << (lsq - 5)) + ft) * (unsigned)(1 << (hdl - 4)) + (unsigned)(cc >> 4)) * 512u + (unsigned)(((cc >> 3) & 1) * 32) * 8u + (a & 31u) * 8u; }
                    *(u32x4*)(base + off) = w; } }
    }
};

#ifndef ZERO_REP
#define ZERO_REP 1
#endif
constexpr int PG8_NX_OFF = 137216;
template <class Epi, class Sched, bool ALIGN_EPI = false, bool SP2 = false>
__device__ __forceinline__ void gemm_phase(PG8_LAS unsigned char* lds, const Gemm g, const Sched& S, const Epi& E, const int wave_in) {
    int tid0; asm volatile("v_mbcnt_lo_u32_b32 %0, -1, 0\n\tv_mbcnt_hi_u32_b32 %0, -1, %0" : "=v"(tid0)); tid0 += wave_in * 64;
    const int tid = tid0, wid = __builtin_amdgcn_readfirstlane(tid >> 6), lane = tid & 63, wr = wid >> 2, wc = wid & 3, fr = lane & 15, fq = lane >> 4;
    const int K = g.K, nt = K / BK;
    unsigned voffA[2], voffB[2];
#pragma unroll
    for (int i = 0; i < 2; ++i) { int R, C; stage_rc(tid * 16 + i * 8192, R, C); const int Rb = Epi::PERM ? ((R & ~31) + perm32(R & 31)) : R;
        voffA[i] = (unsigned)(R * K + C) * 2u; voffB[i] = (unsigned)(Rb * K + C) * 2u; }
    const size_t kstep = (size_t)(BK * 2);
    const size_t hstep = (size_t)HALF * K * 2;
    const size_t tstep = 2 * hstep;
    const unsigned ldsw = (unsigned)wid * 1024u;
    const int aoff = lds_byte(wr * 64 + fr, fq * 8), boff = lds_byte(wc * 32 + fr, fq * 8);
#define PG8_SA(b, h) (((b) * 2 + (h)) * HTB)
#define PG8_SB(b, h) ((4 + (b) * 2 + (h)) * HTB)
#define PG8_STAGE(bufoff, gbase, voff) do { _Pragma("unroll") for (int _i = 0; _i < 2; ++_i) \
        __builtin_amdgcn_global_load_lds((const unsigned*)((const char*)(gbase) + (voff)[_i]), (PG8_LAS unsigned*)(lds + (bufoff) + ldsw + _i * 8192), 16, 0, 0); } while (0)
#define PG8_LDA(dst, b, h) do { _Pragma("unroll") for (int m = 0; m < 4; ++m) _Pragma("unroll") for (int k = 0; k < 2; ++k) dst[m][k] = *(const PG8_LAS bf16x8*)(lds + PG8_SA(b, h) + aoff + m * 2048 + k * 1024); } while (0)
#define PG8_LDB(dst, b, h) do { _Pragma("unroll") for (int n = 0; n < 2; ++n) _Pragma("unroll") for (int k = 0; k < 2; ++k) dst[n][k] = *(const PG8_LAS bf16x8*)(lds + PG8_SB(b, h) + boff + n * 2048 + k * 1024); } while (0)
#define PG8_MMA(ai, bj, At, Bt) do { __builtin_amdgcn_s_setprio(1); _Pragma("unroll") for (int m = 0; m < 4; ++m) _Pragma("unroll") for (int n = 0; n < 2; ++n) _Pragma("unroll") for (int k = 0; k < 2; ++k) \
        acc[ai][bj][m][n] = st16::mfma16(Bt[n][k], At[m][k], acc[ai][bj][m][n]); __builtin_amdgcn_s_setprio(0); } while (0)
#define PG8_WAIT_V(n) asm volatile("s_waitcnt vmcnt(" #n ")" ::: "memory")
#define PG8_WAIT_L(n) asm volatile("s_waitcnt lgkmcnt(" #n ")" ::: "memory")
#define PG8_BAR __builtin_amdgcn_s_barrier()
#define PG8_SCHED __builtin_amdgcn_sched_barrier(0)
    typedef float f32x2z __attribute__((ext_vector_type(2)));
    Unit cur, nxt; int ui = 0;
    if (!S.next(0, cur)) return;
    f32x4 acc[2][2][4][2];
    typename Epi::Pre pre;
#pragma unroll
    for (int a = 0; a < 2; ++a)
#pragma unroll
        for (int b = 0; b < 2; ++b)
#pragma unroll
            for (int m = 0; m < 4; ++m)
#pragma unroll
                for (int n = 0; n < 2; ++n) { f32x2z z0_, z1_; asm volatile("v_mov_b64 %0, 0" : "=v"(z0_)); asm volatile("v_mov_b64 %0, 0" : "=v"(z1_));
                    acc[a][b][m][n] = (f32x4){z0_[0], z0_[1], z1_[0], z1_[1]}; }
    bf16x8 At[4][2], B0[2][2], B1[2][2];
    const char* cA = (const char*)g.A + (size_t)cur.pm * tstep; const char* cB = (const char*)g.Bt + (size_t)cur.pn * tstep;
    S.a_ready(cur);
    PG8_LAS float* const nxslot = (PG8_LAS float*)(lds + PG8_NX_OFF + wid * 1024);
    typename Epi::Nx nx0; E.nx_issue(nx0, cur, wr, lane); E.nx_commit(nx0, nxslot, lane);
    if constexpr (SP2) {
        PG8_STAGE(PG8_SB(0, 0), cB, voffB); PG8_STAGE(PG8_SB(0, 1), cB + hstep, voffB); PG8_STAGE(PG8_SA(0, 0), cA, voffA); PG8_STAGE(PG8_SA(0, 1), cA + hstep, voffA);
        if (wr == 1) PG8_BAR;
        PG8_WAIT_V(2); PG8_BAR;
        PG8_STAGE(PG8_SB(1, 0), cB + kstep, voffB); PG8_STAGE(PG8_SA(1, 0), cA + kstep, voffA); PG8_STAGE(PG8_SB(1, 1), cB + hstep + kstep, voffB);
        PG8_WAIT_V(6); PG8_BAR;
    } else {
        PG8_STAGE(PG8_SB(0, 0), cB, voffB); PG8_STAGE(PG8_SA(0, 0), cA, voffA); PG8_STAGE(PG8_SB(0, 1), cB + hstep, voffB); PG8_STAGE(PG8_SA(0, 1), cA + hstep, voffA);
        if (wr == 1) PG8_BAR;
        PG8_WAIT_V(4); PG8_BAR;
        PG8_STAGE(PG8_SB(1, 0), cB + kstep, voffB); PG8_STAGE(PG8_SA(1, 0), cA + kstep, voffA); PG8_STAGE(PG8_SB(1, 1), cB + hstep + kstep, voffB);
        PG8_WAIT_V(6); PG8_BAR;
    }
    for (;;) {
        const bool has_next = S.next(ui + 1, nxt);
        const char* nA = has_next ? (const char*)g.A + (size_t)nxt.pm * tstep : cA; const char* nB = has_next ? (const char*)g.Bt + (size_t)nxt.pn * tstep : cB;
        for (int t = 0; t < nt; t += 2) {
            const bool last = (t == nt - 2);
            const char* a1 = cA + (size_t)(t + 1) * kstep;
            const char* a2 = last ? nA : cA + (size_t)(t + 2) * kstep; const char* b2 = last ? nB : cB + (size_t)(t + 2) * kstep;
            const char* a3 = a2 + kstep; const char* b3 = b2 + kstep;
            if (last && has_next) S.a_ready(nxt);
            if (last) E.prefetch(pre, cur, wr, wc, fr, fq);
            if constexpr (SP2) {
            PG8_LDB(B0, 0, 0); PG8_LDB(B1, 0, 1); PG8_SCHED; PG8_LDA(At, 0, 0); PG8_STAGE(PG8_SA(1, 1), a1 + hstep, voffA);
            PG8_WAIT_V(8); PG8_WAIT_L(0); PG8_BAR; PG8_MMA(0, 0, At, B0); PG8_MMA(0, 1, At, B1); PG8_BAR; PG8_SCHED;
            PG8_LDA(At, 0, 1); PG8_STAGE(PG8_SB(0, 0), b2, voffB); PG8_STAGE(PG8_SB(0, 1), b2 + hstep, voffB); PG8_STAGE(PG8_SA(0, 0), a2, voffA);
            PG8_WAIT_V(8); PG8_WAIT_L(0); PG8_BAR; PG8_MMA(1, 0, At, B0); PG8_MMA(1, 1, At, B1); PG8_BAR; PG8_SCHED;
            PG8_LDB(B0, 1, 0); PG8_LDB(B1, 1, 1); PG8_SCHED; PG8_LDA(At, 1, 0); PG8_STAGE(PG8_SA(0, 1), a2 + hstep, voffA);
            PG8_WAIT_V(8); PG8_WAIT_L(0); PG8_BAR; PG8_MMA(0, 0, At, B0); PG8_MMA(0, 1, At, B1); PG8_BAR; PG8_SCHED;
            PG8_LDA(At, 1, 1); PG8_STAGE(PG8_SB(1, 0), b3, voffB); PG8_STAGE(PG8_SB(1, 1), b3 + hstep, voffB); PG8_STAGE(PG8_SA(1, 0), a3, voffA);
            PG8_WAIT_V(8); PG8_WAIT_L(0); PG8_BAR; PG8_MMA(1, 0, At, B0); PG8_MMA(1, 1, At, B1); PG8_BAR; PG8_SCHED;
            } else {
            PG8_LDB(B0, 0, 0); PG8_SCHED; PG8_LDA(At, 0, 0); PG8_STAGE(PG8_SA(1, 1), a1 + hstep, voffA);
            PG8_WAIT_L(8); PG8_BAR; PG8_WAIT_L(0); PG8_MMA(0, 0, At, B0); PG8_BAR; PG8_SCHED;
            PG8_LDB(B1, 0, 1); PG8_STAGE(PG8_SB(0, 0), b2, voffB);
            PG8_BAR; PG8_WAIT_L(0); PG8_MMA(0, 1, At, B1); PG8_BAR;
            PG8_LDA(At, 0, 1); PG8_STAGE(PG8_SA(0, 0), a2, voffA);
            PG8_BAR; PG8_WAIT_L(0); PG8_MMA(1, 0, At, B0); PG8_BAR; PG8_SCHED;
            PG8_STAGE(PG8_SB(0, 1), b2 + hstep, voffB);
            PG8_WAIT_V(6); PG8_BAR; PG8_MMA(1, 1, At, B1); PG8_BAR;
            PG8_LDB(B0, 1, 0); PG8_SCHED; PG8_LDA(At, 1, 0); PG8_STAGE(PG8_SA(0, 1), a2 + hstep, voffA);
            PG8_WAIT_L(8); PG8_BAR; PG8_WAIT_L(0); PG8_MMA(0, 0, At, B0); PG8_BAR; PG8_SCHED;
            PG8_LDB(B1, 1, 1); PG8_STAGE(PG8_SB(1, 0), b3, voffB);
            PG8_BAR; PG8_WAIT_L(0); PG8_MMA(0, 1, At, B1); PG8_BAR;
            PG8_LDA(At, 1, 1); PG8_STAGE(PG8_SA(1, 0), a3, voffA);
            PG8_BAR; PG8_WAIT_L(0); PG8_MMA(1, 0, At, B0); PG8_BAR; PG8_SCHED;
            PG8_STAGE(PG8_SB(1, 1), b3 + hstep, voffB);
            PG8_WAIT_V(6); PG8_BAR; PG8_MMA(1, 1, At, B1); PG8_BAR;
            }
        }
        if constexpr (ALIGN_EPI) { if (wr == 0) PG8_BAR; }
        if constexpr (!Epi::AFTER_DRAIN) {
            for (int er_ = 0; er_ < Epi::REP; ++er_) E(acc, cur, wr, wc, fr, fq, pre, nxslot);
            if (has_next && nxt.pm != cur.pm) { typename Epi::Nx nx1; E.nx_issue(nx1, nxt, wr, lane); E.nx_commit(nx1, nxslot, lane); }
            S.done(cur); }
        if (!has_next) break;
        for (int zr_ = 0; zr_ < ZERO_REP; ++zr_)
#pragma unroll
        for (int a = 0; a < 2; ++a)
#pragma unroll
            for (int b = 0; b < 2; ++b)
#pragma unroll
                for (int m = 0; m < 4; ++m)
#pragma unroll
                    for (int n = 0; n < 2; ++n) { f32x2z z0_, z1_; asm volatile("v_mov_b64 %0, 0" : "=v"(z0_)); asm volatile("v_mov_b64 %0, 0" : "=v"(z1_));
                    acc[a][b][m][n] = (f32x4){z0_[0], z0_[1], z1_[0], z1_[1]}; }
        cur = nxt; cA = nA; cB = nB; ++ui;
        if constexpr (ALIGN_EPI) { if (wr == 1) PG8_BAR; }
    }
    PG8_WAIT_V(0);
    if constexpr (!ALIGN_EPI) { if (wr == 0) PG8_BAR; }
    PG8_BAR;
    if constexpr (Epi::AFTER_DRAIN) { E.fused(acc, cur, wr, wc, fr, fq, lds, wid, lane); S.done(cur); }
#undef PG8_SA
#undef PG8_SB
#undef PG8_STAGE
#undef PG8_LDA
#undef PG8_LDB
#undef PG8_MMA
#undef PG8_WAIT_V
#undef PG8_WAIT_L
#undef PG8_BAR
#undef PG8_SCHED
}
}

namespace wa {
#ifndef WA_MASK_SKIP
#define WA_MASK_SKIP 1
#endif
#define WA_LAS __attribute__((address_space(3)))
typedef unsigned short bf16_t;
typedef short bf16x8 __attribute__((ext_vector_type(8)));
typedef short s16x4 __attribute__((ext_vector_type(4)));
typedef float f32x16 __attribute__((ext_vector_type(16)));
typedef float f32x4 __attribute__((ext_vector_type(4)));
typedef unsigned u32x4 __attribute__((ext_vector_type(4)));
typedef unsigned u32x2 __attribute__((ext_vector_type(2)));
constexpr float LOG2E = 1.4426950408889634f, LN2 = 0.6931471805599453f;
__device__ __forceinline__ unsigned cvtpk(float lo, float hi) { return st16::pack(lo, hi); }
__device__ __forceinline__ s16x4 vtr(const WA_LAS unsigned char* p) { return __builtin_bit_cast(s16x4, __builtin_amdgcn_ds_read_tr16_b64_v4i16((WA_LAS s16x4*)p)); }
__device__ __forceinline__ int kofs(int reg, int hh) { return (reg & 3) + 8 * (reg >> 2) + 4 * hh; }

template <int HD> struct VRegs { u32x4 t[32 / (64 / (HD / 8))]; };
template <int HD> __device__ __forceinline__ void load_v(VRegs<HD>& R, const bf16_t* v, long vstride, int kp0, int nkeys, int lane) {
    constexpr int LPR = HD / 8  , RPI = 64 / LPR  ;
#pragma unroll
    for (int i = 0; i < 32 / RPI; ++i) { const int row = i * RPI + lane / LPR; int kp = kp0 + row; kp = kp < 0 ? 0 : (kp >= nkeys ? nkeys - 1 : kp);
        R.t[i] = *(const u32x4*)(v + (long)kp * vstride + (lane % LPR) * 8); }
}
template <int HD> __device__ __forceinline__ void write_v(const VRegs<HD>& R, WA_LAS unsigned char* vl, int lane) {
    constexpr int VP = HD * 2 + 64, LPR = HD / 8, RPI = 64 / LPR;
#pragma unroll
    for (int i = 0; i < 32 / RPI; ++i) { const int row = i * RPI + lane / LPR; *(WA_LAS u32x4*)(vl + row * VP + (lane % LPR) * 16) = R.t[i]; }
}
template <int HD> __device__ __forceinline__ void stage_v(WA_LAS unsigned char* vl, const bf16_t* v, long vstride, int kp0, int nkeys, int lane) {
    VRegs<HD> R; load_v<HD>(R, v, vstride, kp0, nkeys, lane); write_v<HD>(R, vl, lane);
}
template <int HD> __device__ __forceinline__ void pv_tile(f32x16 (&o)[HD / 32], const f32x16& p, const WA_LAS unsigned char* vl, int lane) {
    constexpr int VP = HD * 2 + 64;
    const int hh = lane >> 5, i16 = lane & 15, q4 = i16 >> 2, p4 = i16 & 3, dsel = (lane >> 4) & 1;
    bf16x8 pb[2];
#pragma unroll
    for (int s2 = 0; s2 < 2; ++s2) { u32x4 w; w.x = cvtpk(p[8 * s2 + 0], p[8 * s2 + 1]); w.y = cvtpk(p[8 * s2 + 2], p[8 * s2 + 3]); w.z = cvtpk(p[8 * s2 + 4], p[8 * s2 + 5]); w.w = cvtpk(p[8 * s2 + 6], p[8 * s2 + 7]);
        pb[s2] = __builtin_bit_cast(bf16x8, w); }
    const WA_LAS unsigned char* base = vl + (4 * hh + q4) * VP + (16 * dsel + 4 * p4) * 2;
#pragma unroll
    for (int dc = 0; dc < HD / 32; ++dc)
#pragma unroll
        for (int s2 = 0; s2 < 2; ++s2) {
            const s16x4 lo = vtr(base + (16 * s2) * VP + dc * 64), hi = vtr(base + (16 * s2 + 8) * VP + dc * 64);
            const bf16x8 a = (bf16x8){lo[0], lo[1], lo[2], lo[3], hi[0], hi[1], hi[2], hi[3]};
            o[dc] = st16::mfma32(a, pb[s2], o[dc]);
        }
}
template <int HD> __device__ __forceinline__ void store_o(const f32x16 (&o)[HD / 32], float scale, bf16_t* orow, int hh) {
#pragma unroll
    for (int dc = 0; dc < HD / 32; ++dc)
#pragma unroll
        for (int g = 0; g < 4; ++g) { u32x2 w; w.x = cvtpk(o[dc][4 * g] * scale, o[dc][4 * g + 1] * scale); w.y = cvtpk(o[dc][4 * g + 2] * scale, o[dc][4 * g + 3] * scale);
            *(u32x2*)(orow + 32 * dc + 8 * g + 4 * hh) = w; }
}

#ifndef WA_OLDS_SM
#define WA_OLDS_SM 1
#endif
#ifndef WA_OLDS_SB
#define WA_OLDS_SB 1
#endif
template <int HD> __device__ __forceinline__ void store_o_lds(const f32x16 (&o)[HD / 32], float scale, bf16_t* obase, long ostride, WA_LAS unsigned char* vl, int lane) {
    constexpr int P = HD * 2 + 16, LPR = HD / 8, RPI = 64 / LPR;
    asm volatile("v_mbcnt_lo_u32_b32 %0, -1, 0\n\tv_mbcnt_hi_u32_b32 %0, -1, %0" : "=v"(lane));
    const int q = lane & 31, hh = lane >> 5;
#pragma unroll
    for (int dc = 0; dc < HD / 32; ++dc)
#pragma unroll
        for (int g = 0; g < 4; ++g) { u32x2 w; w.x = cvtpk(o[dc][4 * g] * scale, o[dc][4 * g + 1] * scale); w.y = cvtpk(o[dc][4 * g + 2] * scale, o[dc][4 * g + 3] * scale);
            *(WA_LAS u32x2*)(vl + q * P + (32 * dc + 8 * g + 4 * hh) * 2) = w; }
#pragma unroll
    for (int j = 0; j < 32 / RPI; ++j) { const int row = j * RPI + lane / LPR;
        const u32x4 w = *(const WA_LAS u32x4*)(vl + row * P + (lane % LPR) * 16);
        *(u32x4*)(obase + (long)row * ostride + (lane % LPR) * 8) = w; }
}

struct SmUnit {
    const bf16_t* q;
    const bf16_t* k;
    const bf16_t* v;
    bf16_t* o;
    long qstride, kstride, vstride, ostride;
    int qpos0, kpos0, nkeys, maxdist, causal;
    float sink;
    float* lse; long lsestride;
    const bf16_t* qt; const bf16_t* kt; int ntiles;
};
template <int HD, int TPC, int NCH, bool SINK, bool LSE, bool TIL, bool ROT = false>
__device__ __forceinline__ void sm_unit(const SmUnit& U, WA_LAS unsigned char* vl, int lane) {
    const int r = lane & 31, hh = lane >> 5;
    bf16x8 qf[HD / 16];
    { const bf16_t* qp = TIL ? U.qt + lane * 8 : U.q + (long)r * U.qstride + 8 * hh;
#pragma unroll
      for (int s = 0; s < HD / 16; ++s) qf[s] = *(const bf16x8*)(qp + (TIL ? 512 : 16) * s); }
    f32x16 o[HD / 32];
#pragma unroll
    for (int dc = 0; dc < HD / 32; ++dc)
#pragma unroll
        for (int i = 0; i < 16; ++i) o[dc][i] = 0.f;
    float m = -1e30f, l = 0.f;
    const int qpos = U.qpos0 + r;
    const int rot = ROT ? (((U.kpos0 >> 5) % TPC) + TPC) % TPC : 0;
#define WA_TT(tau_) ((tau_) - rot < 0 ? (tau_) - rot + TPC : (tau_) - rot)
#pragma unroll 1
    for (int ch = 0; ch < NCH; ++ch) {
        const int kb = U.kpos0 + ch * TPC * 32;
        f32x16 S[TPC];
        constexpr bool VPF = (NCH == 1);
        VRegs<HD> vr; if (VPF) load_v<HD>(vr, U.v, U.vstride, kb + 32 * WA_TT(0), U.nkeys, lane);
        bf16x8 kf[HD / 16];
#define WA_KLOAD(dst, t_) do { int kp_ = kb + 32 * WA_TT(t_) + r; kp_ = kp_ < 0 ? 0 : (kp_ >= U.nkeys ? U.nkeys - 1 : kp_); int ti_ = (kb >> 5) + WA_TT(t_); ti_ = ti_ < 0 ? 0 : (ti_ >= U.ntiles ? U.ntiles - 1 : ti_); \
            const bf16_t* kptr_ = TIL ? U.kt + (long)ti_ * (HD / 16) * 512 + lane * 8 : U.k + (long)kp_ * U.kstride + 8 * hh; \
            _Pragma("unroll") for (int s = 0; s < HD / 16; ++s) dst[s] = *(const bf16x8*)(kptr_ + (TIL ? 512 : 16) * s); } while (0)
        WA_KLOAD(kf, 0);
#pragma unroll
        for (int t = 0; t < TPC; ++t) {
            bf16x8 kn[HD / 16];
            if (t + 1 < TPC) WA_KLOAD(kn, t + 1);
            asm volatile("" ::: "memory");
#pragma unroll
            for (int i = 0; i < 16; ++i) S[t][i] = 0.f;
#pragma unroll
            for (int s = 0; s < HD / 16; ++s) S[t] = st16::mfma32(kf[s], qf[s], S[t]);
            if (t + 1 < TPC) {
#pragma unroll
                for (int s = 0; s < HD / 16; ++s) kf[s] = kn[s]; }
        }
#undef WA_KLOAD
        float cm = -1e30f;
#pragma unroll
        for (int t = 0; t < TPC; ++t) {
            const int p0 = kb + 32 * WA_TT(t), p1 = p0 + 31;
            const bool allv = WA_MASK_SKIP && (p0 >= 0) && (p1 < U.nkeys) && (!U.causal || p1 <= U.qpos0) && (U.qpos0 + 31 - p0 <= U.maxdist);
            if (allv) {
#pragma unroll
                for (int i = 0; i < 16; ++i) cm = fmaxf(cm, S[t][i]);
            } else {
#pragma unroll
                for (int i = 0; i < 16; ++i) { const int kp = p0 + kofs(i, hh);
                    const bool ok = (kp >= 0) && (kp < U.nkeys) && (!U.causal || kp <= qpos) && (qpos - kp <= U.maxdist);
                    const float sv = ok ? S[t][i] : -INFINITY; S[t][i] = sv; cm = fmaxf(cm, sv); }
            }
        }
        cm = fmaxf(cm, __shfl_xor(cm, 32));
        if (SINK && ch == 0) cm = fmaxf(cm, U.sink);
        const float mn = fmaxf(m, cm), alpha = __builtin_amdgcn_exp2f(m - mn);
        float ps = 0.f;
#pragma unroll
        for (int t = 0; t < TPC; ++t)
#pragma unroll
            for (int i = 0; i < 16; ++i) { const float p = __builtin_amdgcn_exp2f(S[t][i] - mn); S[t][i] = p; ps += p; }
        ps += __shfl_xor(ps, 32);
        if (SINK && ch == 0) ps += __builtin_amdgcn_exp2f(U.sink - mn);
        l = l * alpha + ps; m = mn;
        if (NCH > 1) {
#pragma unroll
            for (int dc = 0; dc < HD / 32; ++dc)
#pragma unroll
                for (int i = 0; i < 16; ++i) o[dc][i] *= alpha; }
        { if (!VPF) load_v<HD>(vr, U.v, U.vstride, kb + 32 * WA_TT(0), U.nkeys, lane);
          asm volatile("" : "+v"(S[0][0]) :: "memory");
#pragma unroll
          for (int t = 0; t < TPC; ++t) {
              VRegs<HD> vn; if (VPF && t + 1 < TPC) load_v<HD>(vn, U.v, U.vstride, kb + 32 * WA_TT(t + 1), U.nkeys, lane);
              write_v<HD>(vr, vl, lane); pv_tile<HD>(o, S[t], vl, lane);
              if (t + 1 < TPC) { if (VPF) vr = vn; else load_v<HD>(vr, U.v, U.vstride, kb + 32 * WA_TT(t + 1), U.nkeys, lane); } } }
    }
#undef WA_TT
    const float inv = 1.0f / l;
    if (WA_OLDS_SM) store_o_lds<HD>(o, inv, U.o, U.ostride, vl, lane); else store_o<HD>(o, inv, U.o + (long)r * U.ostride, hh);
    if (LSE) { if (hh == 0) U.lse[(long)r * U.lsestride] = (m + __builtin_amdgcn_logf(l)) * LN2; }
}

#ifndef SB_EARLY_EXIT
#define SB_EARLY_EXIT 1
#endif
constexpr float SB_EXIT_T = 110.0f;
template <int HD>
__device__ __forceinline__ void sb_unit(const bf16_t* qT, const bf16_t* kT, const bf16_t* v, bf16_t* o, long stride, int qpos0, WA_LAS unsigned char* vl, int lane) {
    const int r = lane & 31, hh = lane >> 5;
    bf16x8 qf[HD / 16];
    { const bf16_t* qp = qT + (long)(qpos0 >> 5) * (HD / 16) * 512 + lane * 8;
#pragma unroll
      for (int s = 0; s < HD / 16; ++s) qf[s] = *(const bf16x8*)(qp + 512 * s); }
    f32x16 oacc[HD / 32];
#pragma unroll
    for (int dc = 0; dc < HD / 32; ++dc)
#pragma unroll
        for (int i = 0; i < 16; ++i) oacc[dc][i] = 0.f;
    float carry = 1.f;
    const int qpos = qpos0 + r, ktd = qpos0 >> 5;
    bf16x8 kf[HD / 16];
    { const bf16_t* kptr = kT + (long)ktd * (HD / 16) * 512 + lane * 8;
#pragma unroll
      for (int s = 0; s < HD / 16; ++s) kf[s] = *(const bf16x8*)(kptr + 512 * s); }
    for (int kt = ktd; kt >= 0; --kt) {
        const int kn = kt > 0 ? kt - 1 : 0;
        VRegs<HD> vr; load_v<HD>(vr, v, stride, 32 * kt, 1 << 30, lane);
        bf16x8 kfn[HD / 16];
        { const bf16_t* kptr = kT + (long)kn * (HD / 16) * 512 + lane * 8;
#pragma unroll
          for (int s = 0; s < HD / 16; ++s) kfn[s] = *(const bf16x8*)(kptr + 512 * s); }
        asm volatile("" ::: "memory");
        f32x16 S;
#pragma unroll
        for (int i = 0; i < 16; ++i) S[i] = 0.f;
#pragma unroll
        for (int s = 0; s < HD / 16; ++s) S = st16::mfma32(kf[s], qf[s], S);
        const bool diag = (kt == ktd);
        float kp[16];
        f32x16 A;
#pragma unroll
        for (int i = 0; i < 16; ++i) { const float z = S[i]; const bool ok = !diag || (32 * kt + kofs(i, hh) < qpos);
            const float ez = __builtin_amdgcn_exp2f(-fabsf(z) * LOG2E), rc = __builtin_amdgcn_rcpf(1.0f + ez), er = ez * rc;
            const float sg = z >= 0.f ? rc : er, kk = z >= 0.f ? er : rc;
            A[i] = ok ? sg : 0.f; kp[i] = ok ? kk : 1.f; }
        float gs[4], pg[4];
#pragma unroll
        for (int g = 0; g < 4; ++g) { gs[g] = (kp[4 * g] * kp[4 * g + 1]) * (kp[4 * g + 2] * kp[4 * g + 3]); pg[g] = __shfl_xor(gs[g], 32); }
        float run = carry;
#pragma unroll
        for (int g = 3; g >= 0; --g) { const float T = run * (hh == 0 ? pg[g] : 1.f);
            const float t3 = T, t2 = t3 * kp[4 * g + 3], t1 = t2 * kp[4 * g + 2], t0 = t1 * kp[4 * g + 1];
            A[4 * g + 3] *= t3; A[4 * g + 2] *= t2; A[4 * g + 1] *= t1; A[4 * g] *= t0;
            run *= gs[g] * pg[g]; }
        carry = run;
        asm volatile("" : "+v"(A[0]), "+v"(A[15]) :: "memory");
        write_v<HD>(vr, vl, lane);
        pv_tile<HD>(oacc, A, vl, lane);
#if SB_EARLY_EXIT
        if (__all(carry == 0.f)) break;
#endif
#pragma unroll
        for (int s = 0; s < HD / 16; ++s) kf[s] = kfn[s];
    }
    if (WA_OLDS_SB) store_o_lds<HD>(oacc, 1.0f, o, stride, vl, lane); else store_o<HD>(oacc, 1.0f, o + (long)r * stride, hh);
}
}

constexpr int NWAVES = 8;
constexpr int BATCH = 4, SEQ = 4096, DM = 2048, DEPTH = 4, NMEM = 256, FF = 5632;
constexpr int MT = BATCH * SEQ;
constexpr int MMEM = BATCH * NMEM;
constexpr size_t MiB = 1u << 20;
constexpr size_t WS_CTL = 0;
constexpr size_t WS_SS = 1 * MiB;
constexpr size_t SS_BYTES = (size_t)MT * 8;
constexpr size_t ZERO_BYTES = 3328 * 1024;
constexpr size_t WS_W = 4 * MiB;
constexpr size_t WL_STRIDE = 168 * MiB, WL_GU1 = 0, WL_DN1 = 44 * MiB, WL_GU2 = 66 * MiB, WL_DN2 = 110 * MiB, WL_MQKV = 132 * MiB, WL_MO = 156 * MiB, WL_XQ = 164 * MiB, WL_XO = 166 * MiB;
constexpr size_t WS_WKV = WS_W + 4 * WL_STRIDE;
constexpr size_t WS_XB = WS_WKV + 16 * MiB;
constexpr size_t WS_MEMB = WS_XB + 64 * MiB;
constexpr size_t WS_ACT = WS_MEMB + 4 * MiB;
constexpr size_t WS_QKV = WS_ACT + 176 * MiB;
constexpr size_t WS_O = WS_QKV + 192 * MiB;
constexpr size_t WS_XQ = WS_O + 64 * MiB;
constexpr size_t WS_XO = WS_XQ + 16 * MiB;
constexpr size_t WS_KVM = WS_XO + 16 * MiB;
constexpr size_t WS_LSE = WS_KVM + 8 * MiB;
constexpr size_t WS_TABD = WS_LSE + 1 * MiB;
constexpr size_t WS_TABS = WS_TABD + 2 * MiB;
constexpr size_t WS_SSMEM = WS_TABS + 1 * MiB;
constexpr size_t WS_END = WS_SSMEM + 1 * MiB;
static_assert(WS_SS + 17 * SS_BYTES <= ZERO_BYTES && ZERO_BYTES <= WS_W, "zeroed region");
static_assert(WS_END < 1400ull * MiB, "workspace map must fit 4x the largest input tensor");
constexpr int CW_BAR = 4096;
constexpr int RING_OFF = 0, RING_BYTES = 131072;
constexpr int LDSCTL_OFF = 135168, MISC_OFF = LDSCTL_OFF + 320;
constexpr int LDS_BYTES = 147456;

#define GAS __attribute__((address_space(1)))
#define LAS __attribute__((address_space(3)))
typedef unsigned short bf16;
typedef unsigned v4u __attribute__((ext_vector_type(4)));
typedef unsigned v2u __attribute__((ext_vector_type(2)));
typedef float f32x4 __attribute__((ext_vector_type(4)));
#define LDS_WAIT() asm volatile("s_waitcnt lgkmcnt(0)" ::: "memory")
#define VM_WAIT() asm volatile("s_waitcnt vmcnt(0)" ::: "memory")
__device__ __forceinline__ unsigned pk2(float lo, float hi) { return pg8::cvt_pk_bf16(lo, hi); }
__device__ __forceinline__ float wave_sum(float v) {
#pragma unroll
    for (int o = 1; o < 64; o <<= 1) v += __shfl_xor(v, o);
    return v;
}
__device__ const float INVF_D[16] = {1.000000000e+00f, 4.403665960e-01f, 1.939227432e-01f, 8.539710194e-02f, 3.760603070e-02f, 1.656043902e-02f, 7.292664610e-03f, 3.211445874e-03f,
                                     1.414213562e-03f, 6.227723788e-04f, 2.742481884e-04f, 1.207697351e-04f, 5.318296098e-05f, 2.341999971e-05f, 1.031338616e-05f, 4.541670478e-06f};
__device__ const float INVF_S[8] = {1.000000000e+00f, 1.939227432e-01f, 3.760603070e-02f, 7.292664610e-03f, 1.414213562e-03f, 2.742481884e-04f, 5.318296098e-05f, 1.031338616e-05f};

#define XB_TMO      128
#define XB_XCNT(j)  (256  + 64 * (j))
#define XB_XSUB(j)  (1280 + 64 * (j))
#define XB_XGEN(j)  (2304 + 64 * (j))
#define XB_TOP      3328
#define XB_TOPGEN   3392
#define XCD_BAR_WORDS 3456
#define XB_SPIN_CAP (1u << 18)
#ifndef XB_FLAT_RELEASE
#define XB_FLAT_RELEASE 1
#endif

__device__ __forceinline__ unsigned xb_ld(unsigned* p)              { return __hip_atomic_load(p, __ATOMIC_RELAXED, __HIP_MEMORY_SCOPE_AGENT); }
__device__ __forceinline__ unsigned xb_add(unsigned* p, unsigned v) { return __hip_atomic_fetch_add(p, v, __ATOMIC_RELAXED, __HIP_MEMORY_SCOPE_AGENT); }
__device__ __forceinline__ unsigned xb_xcc_id() { return (unsigned)__builtin_amdgcn_s_getreg((3 << 11) | 20) & 0xFu; }
#define XB_SPIN(cond, bar) do { unsigned _sp = 0; while (cond) { __builtin_amdgcn_s_sleep(1); \
    if ((++_sp & 255u) == 0u) { if (xb_ld(&(bar)[XB_TMO])) break; if (_sp > XB_SPIN_CAP) { atomicAdd(&(bar)[XB_TMO], 1u); break; } } } } while (0)

struct XcdBarrier {
    unsigned* bar; unsigned x; unsigned ng;
    volatile LAS unsigned* st;
};

__device__ __forceinline__ XcdBarrier xcd_barrier_post(unsigned* bar, volatile LAS unsigned* st, const bool t0  ) {
    XcdBarrier b; b.bar = bar; b.x = xb_xcc_id(); b.st = st; b.ng = 0u;
    if (t0) (void)xb_add(&bar[XB_XCNT(b.x)], 1u);
    return b;
}
__device__ __forceinline__ void xcd_barrier_complete(unsigned* bar, unsigned x, unsigned& nloc, unsigned& nx, const unsigned G) {
    unsigned sum, cnt, mine, sp = 0u;
    for (;;) {
        sum = 0u; cnt = 0u; mine = 0u;
#pragma unroll
        for (unsigned j = 0; j < 16; ++j) { const unsigned c = xb_ld(&bar[XB_XCNT(j)]); sum += c; cnt += (c > 0u) ? 1u : 0u; mine = (j == x) ? c : mine; }
        if (sum == G) break;
        __builtin_amdgcn_s_sleep(1);
        if ((++sp & 255u) == 0u) { if (xb_ld(&bar[XB_TMO])) break; if (sp > XB_SPIN_CAP) { atomicAdd(&bar[XB_TMO], 1u); break; } }
    }
    nloc = mine > 0u ? mine : 1u; nx = cnt > 0u ? cnt : 1u;
}

__device__ __forceinline__ void xcd_barrier(const XcdBarrier& b, const bool t0) {
    asm volatile("s_waitcnt vmcnt(0)" ::: "memory");
    __syncthreads();
    if (t0) {
        unsigned* bar = b.bar;
        __builtin_amdgcn_s_waitcnt(0);
        unsigned nloc = b.st[0], nx = b.st[1];
        if (nloc == 0u) { xcd_barrier_complete(bar, b.x, nloc, nx, b.ng); b.st[0] = nloc; b.st[1] = nx; }
        const unsigned old = xb_add(&bar[XB_XSUB(b.x)], 1u);
        const unsigned gen = old / nloc;
        if (old + 1u == (gen + 1u) * nloc) {
            __builtin_amdgcn_fence(__ATOMIC_RELEASE, "agent");
            asm volatile("s_waitcnt vmcnt(0)" ::: "memory");
            const unsigned og = xb_add(&bar[XB_TOP], 1u);
            const unsigned tg = og / nx;
            if (og + 1u == (tg + 1u) * nx) xb_add(&bar[XB_TOPGEN], 1u);
            else XB_SPIN(xb_ld(&bar[XB_TOPGEN]) == tg, bar);
            __builtin_amdgcn_fence(__ATOMIC_ACQUIRE, "agent");
            if (!XB_FLAT_RELEASE) xb_add(&bar[XB_XGEN(b.x)], 1u);
            asm volatile("s_waitcnt vmcnt(0)" ::: "memory");
        } else {
            if (XB_FLAT_RELEASE) XB_SPIN(xb_ld(&bar[XB_TOPGEN]) == gen, bar);
            else XB_SPIN(xb_ld(&bar[XB_XGEN(b.x)]) == gen, bar);
            __builtin_amdgcn_fence(__ATOMIC_ACQUIRE, "agent");
            asm volatile("s_waitcnt vmcnt(0)" ::: "memory");
        }
    }
    __syncthreads();
}

__device__ __forceinline__ void conv_items(int& it, const int NGW, const float* W, const int K, const int N, const float* gain, const float scale, bf16* WT, const int mode, const int lane) {
    const int nblk = N >> 6, nitems = (K >> 6) * nblk, g = lane >> 4, j = lane & 15;
    while (it < nitems) {
        const int kb = it / nblk, nb = it - kb * nblk, k0 = kb << 6, n0 = nb << 6;
        const float* src = W + (size_t)(k0 + 16 * g) * N + n0 + 4 * j;
        f32x4 t[16];
#pragma unroll
        for (int i = 0; i < 16; ++i) t[i] = *(const f32x4*)(src + (size_t)i * N);
        f32x4 gv[4];
#pragma unroll
        for (int q = 0; q < 4; ++q) gv[q] = gain ? *(const f32x4*)(gain + k0 + 16 * g + 4 * q) * scale : (f32x4){scale, scale, scale, scale};
        int drow0 = n0; if (mode == 1) { const int hf = n0 >= FF ? 1 : 0; const int j0 = n0 - hf * FF; drow0 = (j0 >> 7) * 256 + hf * 128 + (j0 & 127); }
        if (mode >= 16) drow0 = (n0 < 512 ? 0 : 2048 - 512) + (mode - 16) * 512 + n0;
#pragma unroll
        for (int c = 0; c < 4; ++c) {
            v4u o0, o1;
            o0.x = pk2(t[0][c] * gv[0][0], t[1][c] * gv[0][1]); o0.y = pk2(t[2][c] * gv[0][2], t[3][c] * gv[0][3]); o0.z = pk2(t[4][c] * gv[1][0], t[5][c] * gv[1][1]); o0.w = pk2(t[6][c] * gv[1][2], t[7][c] * gv[1][3]);
            o1.x = pk2(t[8][c] * gv[2][0], t[9][c] * gv[2][1]); o1.y = pk2(t[10][c] * gv[2][2], t[11][c] * gv[2][3]); o1.z = pk2(t[12][c] * gv[3][0], t[13][c] * gv[3][1]); o1.w = pk2(t[14][c] * gv[3][2], t[15][c] * gv[3][3]);
            bf16* dst = WT + (size_t)(drow0 + 4 * j + c) * K + k0 + 16 * g;
            *(v4u*)dst = o0; *(v4u*)(dst + 8) = o1;
        }
        it += NGW;
    }
    it -= nitems;
}
__device__ __forceinline__ void row_to_bf16_ss(const float* xrow, bf16* orow, pg8::ssq_t* ssp, const int lane) {
    const f32x4* xr = (const f32x4*)xrow + lane; f32x4 v[8]; float s = 0.f;
#pragma unroll
    for (int j = 0; j < 8; ++j) { v[j] = xr[64 * j]; s += (v[j].x * v[j].x + v[j].y * v[j].y) + (v[j].z * v[j].z + v[j].w * v[j].w); }
    s = wave_sum(s);
    v2u* o8 = (v2u*)orow + lane;
#pragma unroll
    for (int j = 0; j < 8; ++j) { v2u w; w.x = pk2(v[j].x, v[j].y); w.y = pk2(v[j].z, v[j].w); o8[64 * j] = w; }
    if (lane == 0) *ssp = pg8::ssq_fix(s);
}

struct Args { const float* in[25]; float* out; unsigned char* ws; int lo, hi; };
constexpr int NPHASES = 43;
#ifndef MK_NG
#define MK_NG 1
#endif
constexpr int NG = MK_NG;

#ifndef MK_ONE_LAUNCH
#define MK_ONE_LAUNCH 1
#endif
#ifndef ATT_REP
#define ATT_REP 1
#endif
#ifndef DIL_XD
#define DIL_XD 1
#endif
#ifndef DIL_ROT
#define DIL_ROT 1
#endif
#ifndef BAR_REP
#define BAR_REP 1
#endif
#ifndef XA_TPC
#define XA_TPC 2
#endif
#ifndef SWA_TIL
#define SWA_TIL 1
#endif
#ifndef SWA_XD
#define SWA_XD 1
#endif
#ifndef PROBE_SAMEKV
#define PROBE_SAMEKV 0
#endif
#ifndef ATT_REP_KIND
#define ATT_REP_KIND -1
#endif
__global__ void __launch_bounds__(NWAVES * 64, 2) mk_fwd(Args args) {
    extern __shared__ __attribute__((aligned(16))) unsigned char lds_raw[];
    LAS unsigned char* lds = (LAS unsigned char*)lds_raw;
    volatile LAS unsigned* MISC = (volatile LAS unsigned*)(lds + MISC_OFF);
    const int wave = __builtin_amdgcn_readfirstlane((int)threadIdx.x >> 6);
#define LANE_ID(v) int v; asm volatile("v_mbcnt_lo_u32_b32 %0, -1, 0\n\tv_mbcnt_hi_u32_b32 %0, -1, %0" : "=v"(v))
    const int G = gridDim.x, bx = blockIdx.x;
    const int vcu = (G % 8 == 0) ? (bx % 8) * (G / 8) + bx / 8 : bx;
    const int gw = vcu * NWAVES + wave, NGW = G * NWAVES;
    const bool grp_ok = (G % (8 * NG) == 0) || NG == 1;
    const int ngr = grp_ok ? NG : 1, XPG = 8 / ngr;
    const int gidx = ngr == 1 ? 0 : (bx % 8) / XPG, lb = ngr == 1 ? bx : (bx / 8) * XPG + (bx % 8) % XPG, GL = G / ngr, nxl = ngr == 1 ? 8 : XPG;
    const int BG = BATCH / ngr, MG = MT / ngr, r0 = gidx * MG, MMG = MMEM / ngr, mr0 = gidx * MMG;
    const int lwv = lb * NWAVES + wave, NLW = GL * NWAVES;
    unsigned char* const ws = args.ws;
    { LANE_ID(l0); const int tid = wave * 64 + l0;
      for (int u = tid; u < (LDS_BYTES - LDSCTL_OFF) / 4; u += NWAVES * 64) ((LAS unsigned*)(lds + LDSCTL_OFF))[u] = 0u;
      __syncthreads();
      (void)xcd_barrier_post((unsigned*)(ws + WS_CTL) + CW_BAR + gidx * XCD_BAR_WORDS, MISC + 8, tid == 0);
      (void)xcd_barrier_post((unsigned*)(ws + WS_CTL) + CW_BAR + NG * XCD_BAR_WORDS, MISC + 12, tid == 0); }
    const int lo = args.lo, hi = args.hi;
    int ph = 0;
#define PH_IF if (ph >= lo && ph < hi)
#define PH_END do { if (ph >= lo && ph + 1 < hi) { XcdBarrier bar_; const bool glob_ = (ph == 0); \
        bar_.bar = (unsigned*)(ws + WS_CTL) + CW_BAR + (glob_ ? NG : gidx) * XCD_BAR_WORDS; bar_.x = xb_xcc_id(); bar_.st = MISC + (glob_ ? 12 : 8); bar_.ng = (unsigned)(glob_ ? G : GL); \
        LANE_ID(lb_); for (int br_ = 0; br_ < BAR_REP; ++br_) xcd_barrier(bar_, wave == 0 && lb_ == 0); } ++ph; } while (0)

#define xout (args.out)
#define xb ((bf16*)(ws + WS_XB))
#define memb ((bf16*)(ws + WS_MEMB))
#define act ((bf16*)(ws + WS_ACT))
#define qbuf ((bf16*)(ws + WS_QKV))
#define kbuf ((bf16*)(ws + WS_QKV + 64 * MiB))
#define vbuf ((bf16*)(ws + WS_QKV + 128 * MiB))
#define obuf ((bf16*)(ws + WS_O))
#define xqbuf ((bf16*)(ws + WS_XQ))
#define xobuf ((bf16*)(ws + WS_XO))
#define kvm ((bf16*)(ws + WS_KVM))
#define ssb ((pg8::ssq_t*)(ws + WS_SS))
#define ssmem ((pg8::ssq_t*)(ws + WS_SSMEM))
#define lseb ((float*)(ws + WS_LSE))
#define tabD ((float*)(ws + WS_TABD))
#define tabS ((float*)(ws + WS_TABS))
#define vl (lds + RING_OFF + wave * 10240)

    PH_IF {
        LANE_ID(lane); const int tid = wave * 64 + lane;
        int it = gw;
        for (int L = 0; L < DEPTH; ++L) {
            unsigned char* wl = ws + WS_W + (size_t)L * WL_STRIDE; const int kind = L % 3, j = L / 3;
            conv_items(it, NGW, args.in[4] + (size_t)L * DM * 2 * FF, DM, 2 * FF, args.in[3] + L * DM, 1.0f, (bf16*)(wl + WL_GU1), 1, lane);
            conv_items(it, NGW, args.in[5] + (size_t)L * FF * DM, FF, DM, nullptr, 0.5f, (bf16*)(wl + WL_DN1), 0, lane);
            conv_items(it, NGW, args.in[22] + (size_t)L * DM * 2 * FF, DM, 2 * FF, args.in[21] + L * DM, 1.0f, (bf16*)(wl + WL_GU2), 1, lane);
            conv_items(it, NGW, args.in[23] + (size_t)L * FF * DM, FF, DM, nullptr, 0.5f, (bf16*)(wl + WL_DN2), 0, lane);
            if (kind == 0) {
                conv_items(it, NGW, args.in[7] + (size_t)j * DM * 6144, DM, 6144, args.in[6] + L * DM, 1.0f, (bf16*)(wl + WL_MQKV), 0, lane);
                conv_items(it, NGW, args.in[8] + (size_t)j * 2048 * DM, 2048, DM, nullptr, 1.0f, (bf16*)(wl + WL_MO), 0, lane);
            } else if (kind == 1) {
                conv_items(it, NGW, args.in[9] + (size_t)j * DM * 4608, DM, 4608, args.in[6] + L * DM, 1.0f, (bf16*)(wl + WL_MQKV), 0, lane);
                conv_items(it, NGW, args.in[10] + (size_t)j * 1536 * DM, 1536, DM, nullptr, 1.0f, (bf16*)(wl + WL_MO), 0, lane);
            } else {
                conv_items(it, NGW, args.in[11] + (size_t)j * DM * 2560, DM, 2560, args.in[6] + L * DM, 1.0f, (bf16*)(wl + WL_MQKV), 0, lane);
                conv_items(it, NGW, args.in[14] + (size_t)j * 2048 * DM, 2048, DM, nullptr, 1.0f, (bf16*)(wl + WL_MO), 0, lane);
            }
            conv_items(it, NGW, args.in[18] + (size_t)L * DM * 512, DM, 512, args.in[16] + L * DM, 1.0f, (bf16*)(wl + WL_XQ), 0, lane);
            conv_items(it, NGW, args.in[19] + (size_t)L * DM * 1024, DM, 1024, args.in[17] + L * DM, 1.0f, (bf16*)(ws + WS_WKV), 16 + L, lane);
            conv_items(it, NGW, args.in[20] + (size_t)L * 512 * DM, 512, DM, nullptr, 1.0f, (bf16*)(wl + WL_XO), 0, lane);
        }
        for (int m = gw; m < MT; m += NGW) row_to_bf16_ss(args.in[0] + (size_t)m * DM, xb + (size_t)m * DM, ssb + m, lane);
        for (int m = gw; m < MMEM; m += NGW) row_to_bf16_ss(args.in[1] + (size_t)m * DM, memb + (size_t)m * DM, ssmem + m, lane);
        const int* pos = (const int*)args.in[2];
        for (int i = bx * (NWAVES * 64) + tid; i < MT * 16; i += G * NWAVES * 64) { const int t = i >> 4, f = i & 15; const float ang = (float)pos[t] * INVF_D[f];
            const double rev = (double)ang * 0.15915494309189535; const float fr = (float)(rev - floor(rev));
            tabD[2 * i] = __builtin_amdgcn_cosf(fr); tabD[2 * i + 1] = __builtin_amdgcn_sinf(fr); }
        for (int i = bx * (NWAVES * 64) + tid; i < MT * 8; i += G * NWAVES * 64) { const int t = i >> 3, f = i & 7; const float ang = (float)pos[t] * INVF_S[f];
            const double rev = (double)ang * 0.15915494309189535; const float fr = (float)(rev - floor(rev));
            tabS[2 * i] = __builtin_amdgcn_cosf(fr); tabS[2 * i + 1] = __builtin_amdgcn_sinf(fr); }
    }
    PH_END;


    for (int s = 0; s < 2 * DEPTH; ++s) {
        const int L = s >> 1, f = s & 1;
        unsigned char* const wl = ws + WS_W + (size_t)L * WL_STRIDE;
        PH_IF {
            pg8::Gemm g{xb + (size_t)r0 * DM, (const bf16*)(wl + (f ? WL_GU2 : WL_GU1)), MG, 2 * FF, DM}; pg8::GroupOrder S; S.init(MG, 2 * FF, GL, lb, nxl);
            pg8::EpiSwiGLU E{act, FF, ssb + (size_t)(4 * L + (f ? 3 : 0)) * MT, r0};
            pg8::gemm_phase<pg8::EpiSwiGLU, pg8::GroupOrder, true, true>(lds + RING_OFF, g, S, E, wave);
        }
        PH_END;
        PH_IF {
            pg8::Gemm g{act + (size_t)r0 * FF, (const bf16*)(wl + (f ? WL_DN2 : WL_DN1)), MG, DM, FF}; pg8::GroupOrder S; S.init(MG, DM, GL, lb, nxl, 4);
            pg8::EpiResid E{xb, ssb + (size_t)(4 * L + (f ? 4 : 1)) * MT, nullptr, r0};
            pg8::gemm_phase<pg8::EpiResid, pg8::GroupOrder, true, true>(lds + RING_OFF, g, S, E, wave);
        }
        PH_END;
        if (f) continue;
        const int kind = L % 3, jm = L / 3;
        PH_IF {
            const int N = kind == 0 ? 6144 : (kind == 1 ? 4608 : 2560);
            pg8::Gemm g{xb + (size_t)r0 * DM, (const bf16*)(wl + WL_MQKV), MG, N, DM}; pg8::GroupOrder S; S.init(MG, N, GL, lb, nxl);
            const pg8::EpiProj E{qbuf, (size_t)(32 * MiB), kind == 1 ? 1536 : 2048, kind == 0 ? 2048 : (kind == 1 ? 1536 : 256), kind == 1 ? 6 : 8, kind == 0 ? 16 : (kind == 1 ? 12 : 9),
                                 ssb + (size_t)(4 * L + 1) * MT, kind == 2 ? args.in[12] + jm * 2560 : nullptr,
                                 kind == 0 ? 0.08838834764831845f : (kind == 1 ? 0.08838834764831845f * 1.4426950408889634f : 0.125f * 1.4426950408889634f),
                                 kind == 0 ? 0 : (kind == 1 ? 128 : 64), kind == 1 ? (const float*)tabD : (const float*)tabS, r0, kind == 0 ? (3 | (4 << 4)) : (kind == 1 ? (3 | (4 << 4) | 256) : (SWA_TIL ? (3 | (4 << 4) | 512) : 0))};
            pg8::gemm_phase<pg8::EpiProj, pg8::GroupOrder, true, true>(lds + RING_OFF, g, S, E, wave);
        }
        PH_END;
        PH_IF for (int rep_ = 0; rep_ < ((ATT_REP_KIND < 0 || ATT_REP_KIND == kind) ? ATT_REP : 1); ++rep_) {
            LANE_ID(lane);
            if (kind == 0) {
                const bool xdeal = (NLW == 256 * nxl) && ((BG * 16) % (2 * nxl) == 0) && (BG * 2048 == 4 * NLW);
                for (int u = lwv; u < BG * 2048; u += NLW) {
                    const int jj = (u / NLW) & 3, wxl = ((lb / nxl) * NWAVES + wave) & 255;
                    const int c = xdeal ? (wxl & 127) : (u & 127), bhl = xdeal ? (lb % nxl) * (BG * 16 / nxl) + 2 * jj + (wxl >> 7) : (u >> 7), a = c & 31, quarter = ((c >> 5) + jj) & 3;
                    const int qb = quarter == 0 ? a : (quarter == 1 ? 63 - a : (quarter == 2 ? 64 + a : 127 - a));
                    const int b = gidx * BG + (bhl >> 4), h = bhl & 15; const size_t base = (size_t)b * SEQ * 2048 + h * 128;
#ifndef MK_NO_SB
                    wa::sb_unit<128>(qbuf + (size_t)(b * 16 + h) * 524288, kbuf + (size_t)(PROBE_SAMEKV && rep_ + 1 < ATT_REP ? 0 : b * 16 + h) * 524288, vbuf + (PROBE_SAMEKV && rep_ + 1 < ATT_REP ? 0 : base), obuf + base + (size_t)(32 * qb) * 2048, 2048, 32 * qb, vl, lane);
#endif
                }
            } else if (kind == 1) {
                const int wpxd = GL / nxl; const bool xd1 = DIL_XD && (GL % nxl == 0) && (wpxd % 16 == 0) && ((BG * 12) % (nxl * (wpxd / 16)) == 0) && (NWAVES == 8);
                for (int u = lwv, kx = 0; u < BG * 1536; u += NLW, ++kx) {
                    const int ppr = wpxd / 16  , jx = lb / nxl;
                    const int idx = xd1 ? (jx & 15) * 8 + wave : (u & 127), hb = xd1 ? ((lb % nxl) * (BG * 12 / nxl) + kx * ppr + (jx >> 4)) : (u >> 7), head = hb % 12, b = gidx * BG + hb / 12, g2 = 2 * (head >> 2), dil = 1 << g2;
                    const int p = idx >> (7 - g2), qb = idx & ((128 >> g2) - 1);
                    const size_t row0 = (size_t)b * SEQ + p; const size_t qrow = row0 + (size_t)(32 * qb) * dil;
                    wa::SmUnit U; U.q = qbuf + qrow * 1536 + head * 128; U.k = kbuf + row0 * 1536 + head * 128; U.v = vbuf + row0 * 1536 + head * 128; U.o = obuf + qrow * 1536 + head * 128;
                    U.qstride = U.kstride = U.vstride = U.ostride = (long)dil * 1536; U.qpos0 = 32 * qb; U.kpos0 = 32 * qb - 128; U.nkeys = SEQ >> g2; U.maxdist = 128; U.causal = 1; U.sink = 0.f;
                    U.lse = lseb + qrow * 12 + head; U.lsestride = (long)dil * 12;
                    U.ntiles = 128 >> g2; U.kt = kbuf + ((size_t)(b * 12 + head) * 128 + (size_t)p * (128 >> g2)) * 4096; U.qt = qbuf + ((size_t)(b * 12 + head) * 128 + (size_t)p * (128 >> g2) + qb) * 4096;
#ifndef MK_NO_DIL
                    wa::sm_unit<128, 5, 1, false, true, true, DIL_ROT != 0>(U, vl, lane);
#endif
                }
            } else {
                const float* sinks = args.in[13] + jm * 32;
                const int wpx = GL / nxl; const bool xd2 = SWA_XD && (GL % nxl == 0) && (128 % wpx == 0) && ((BG * 4) % nxl == 0) && (NWAVES == 8);
                for (int u = lwv, kx = 0; u < BG * 4096; u += NLW, ++kx) {
                    const int ppp = 128 / wpx, pr = (lb % nxl) * (BG * 4 / nxl) + kx / ppp;
                    const int hq = u & 7, qb = xd2 ? (kx % ppp) * wpx + lb / nxl : (u >> 3) & 127, kvh = xd2 ? (pr & 3) : (u >> 10) & 3, b = gidx * BG + (xd2 ? (pr >> 2) : (u >> 12)), head = kvh * 8 + hq;
                    const size_t row0 = (size_t)b * SEQ, qrow = row0 + 32 * qb;
                    wa::SmUnit U; U.q = qbuf + qrow * 2048 + head * 64; U.k = kbuf + row0 * 256 + kvh * 64; U.v = vbuf + row0 * 256 + kvh * 64; U.o = obuf + qrow * 2048 + head * 64;
                    U.qstride = 2048; U.kstride = 256; U.vstride = 256; U.ostride = 2048; U.qpos0 = 32 * qb; U.kpos0 = 32 * qb - 128; U.nkeys = SEQ; U.maxdist = 127; U.causal = 1;
                    U.sink = sinks[head] * 1.4426950408889634f; U.lse = nullptr; U.lsestride = 0; U.qt = qbuf + ((size_t)(b * 32 + head) * 128 + qb) * 2048; U.kt = kbuf + (size_t)(b * 4 + kvh) * 128 * 2048; U.ntiles = 128;
#ifndef MK_NO_SWA
                    wa::sm_unit<64, 5, 1, true, false, SWA_TIL != 0>(U, vl, lane);
#endif
                }
            }
        }
        PH_END;
        if (kind == 1) {
            PH_IF {
                LANE_ID(lane); const int tid = wave * 64 + lane;
                for (int il = lb * (NWAVES * 64) + tid; il < MG * 192; il += GL * NWAVES * 64) { const int i = r0 * 192 + il; const int row = i / 192, c8 = i - row * 192, head = c8 >> 4, g = head >> 2, jj = head & 3;
                    const float l0 = lseb[row * 12 + jj], l1 = lseb[row * 12 + 4 + jj], l2 = lseb[row * 12 + 8 + jj]; const float mx = fmaxf(l0, fmaxf(l1, l2));
                    const float e0 = __expf(l0 - mx), e1 = __expf(l1 - mx), e2 = __expf(l2 - mx); const float al = (g == 0 ? e0 : (g == 1 ? e1 : e2)) / (e0 + e1 + e2);
                    v4u w = *(v4u*)(obuf + (size_t)i * 8); v4u o;
#define SC2(x) pk2(st16::lo(x) * al, st16::hi(x) * al)
                    o.x = SC2(w.x); o.y = SC2(w.y); o.z = SC2(w.z); o.w = SC2(w.w);
#undef SC2
                    *(v4u*)(obuf + (size_t)i * 8) = o; }
            }
            PH_END;
        }
        PH_IF {
            const int Ko = kind == 1 ? 1536 : 2048;
            pg8::Gemm g{obuf + (size_t)r0 * Ko, (const bf16*)(wl + WL_MO), MG, DM, Ko}; pg8::GroupOrder S; S.init(MG, DM, GL, lb, nxl, 4);
            pg8::EpiResid E{xb, ssb + (size_t)(4 * L + 2) * MT, kind == 2 ? args.in[15] + jm * DM : nullptr, r0};
            pg8::gemm_phase<pg8::EpiResid, pg8::GroupOrder, true, true>(lds + RING_OFF, g, S, E, wave);
        }
        PH_END;
        PH_IF {
            if (L == 0 && lb >= GL / 2) {
                pg8::Gemm g{memb + (size_t)mr0 * DM, (const bf16*)(ws + WS_WKV), MMG, 4096, DM}; pg8::GroupOrder S; S.init(MMG, 4096, GL / 2, lb - GL / 2, nxl);
                const pg8::EpiProj E{kvm, (size_t)MMEM * 2048, 2048, 2048, 8, 1 << 30, ssmem, nullptr, 1.0f, 0, nullptr, mr0, 1};
                pg8::gemm_phase<pg8::EpiProj, pg8::GroupOrder, true, true>(lds + RING_OFF, g, S, E, wave);
            }
            pg8::Gemm g{xb + (size_t)r0 * DM, (const bf16*)(wl + WL_XQ), MG, 512, DM}; pg8::GroupOrder S; S.init(MG, 512, GL, lb, nxl);
            const pg8::EpiProj E{xqbuf, 0, 512, 512, 1 << 30, 1 << 30, ssb + (size_t)(4 * L + 2) * MT, nullptr, 0.08838834764831845f * 1.4426950408889634f, 0, nullptr, r0, 1 | (4 << 4)};
            pg8::gemm_phase<pg8::EpiProj, pg8::GroupOrder, true, true>(lds + RING_OFF, g, S, E, wave);
        }
        PH_END;
        PH_IF for (int rep_ = 0; rep_ < ((ATT_REP_KIND < 0 || ATT_REP_KIND == 3) ? ATT_REP : 1); ++rep_) {
            LANE_ID(lane);
            for (int u = lwv; u < BG * 512; u += NLW) {
                const int qb = u & 127, h = (u >> 7) & 3, b = gidx * BG + (u >> 9); const size_t qrow = (size_t)b * SEQ + 32 * qb;
                wa::SmUnit U; U.q = nullptr; U.k = nullptr; U.v = kvm + (size_t)MMEM * 2048 + (size_t)b * NMEM * 2048 + L * 512 + h * 128; U.o = xobuf + qrow * 512 + h * 128;
                U.qt = xqbuf + ((size_t)(b * 4 + h) * 128 + qb) * 4096; U.kt = kvm + (size_t)(b * 16 + L * 4 + h) * 8 * 4096; U.ntiles = 8;
                U.qstride = 512; U.kstride = 2048; U.vstride = 2048; U.ostride = 512; U.qpos0 = 32 * qb; U.kpos0 = 0; U.nkeys = NMEM; U.maxdist = 1 << 30; U.causal = 0; U.sink = 0.f; U.lse = nullptr; U.lsestride = 0;
#ifndef MK_NO_XA
                wa::sm_unit<128, XA_TPC, 8 / XA_TPC, false, false, true>(U, vl, lane);
#endif
            }
        }
        PH_END;
        PH_IF {
            pg8::Gemm g{xobuf + (size_t)r0 * 512, (const bf16*)(wl + WL_XO), MG, DM, 512}; pg8::GroupOrder S; S.init(MG, DM, GL, lb, nxl, 4);
            pg8::EpiResid E{xb, ssb + (size_t)(4 * L + 3) * MT, nullptr, r0};
            pg8::gemm_phase<pg8::EpiResid, pg8::GroupOrder, true, true>(lds + RING_OFF, g, S, E, wave);
        }
        PH_END;
    }
    PH_IF {
        LANE_ID(lane);
        const pg8::ssq_t* ssf = ssb + (size_t)16 * MT; const f32x4* gn = (const f32x4*)args.in[24] + lane;
        for (int m = r0 + lwv; m < r0 + MG; m += NLW) { const float ri = pg8::rinv_of(ssf, m); f32x4* xr = (f32x4*)(xout + (size_t)m * DM) + lane; const v2u* xi = (const v2u*)(xb + (size_t)m * DM) + lane;
#pragma unroll
            for (int j = 0; j < 8; ++j) { const v2u w = xi[64 * j]; const f32x4 gg = gn[64 * j];
                f32x4 v; v[0] = st16::lo(w.x); v[1] = st16::hi(w.x); v[2] = st16::lo(w.y); v[3] = st16::hi(w.y);
                xr[64 * j] = v * ri * gg; } }
    }
    PH_END;
#undef PH_IF
#undef PH_END
}

extern "C" void kernel_launch(void* const* d_in, const int* in_sizes, int n_in, void* d_out, int out_size, void* d_ws, size_t ws_size, hipStream_t stream) {
    static int grid = 0;
    if (grid == 0) {
        if (n_in != 25 || out_size != MT * DM || ws_size < WS_END) { fprintf(stderr, "kernel_launch: unexpected shapes (n_in %d, out %d, ws %zu < %zu); nothing launched\n", n_in, out_size, ws_size, (size_t)WS_END); grid = -1; return; }
        int dev = 0, cus = 0, per_cu = 0;
        if (hipGetDevice(&dev) != hipSuccess || hipDeviceGetAttribute(&cus, hipDeviceAttributeMultiprocessorCount, dev) != hipSuccess) { fprintf(stderr, "kernel_launch: device query failed\n"); grid = -1; return; }
        if (hipFuncSetAttribute((const void*)mk_fwd, hipFuncAttributeMaxDynamicSharedMemorySize, LDS_BYTES) != hipSuccess) { fprintf(stderr, "kernel_launch: hipFuncSetAttribute failed\n"); grid = -1; return; }
        if (hipOccupancyMaxActiveBlocksPerMultiprocessor(&per_cu, (const void*)mk_fwd, NWAVES * 64, LDS_BYTES) != hipSuccess || per_cu < 1)
            fprintf(stderr, "kernel_launch: note: occupancy query reports %d workgroups per CU\n", per_cu);
        (void)hipGetLastError();
        grid = cus;
    }
    if (grid < 0) return;
    if (hipMemsetAsync((char*)d_ws + WS_CTL, 0, ZERO_BYTES, stream) != hipSuccess) { fprintf(stderr, "kernel_launch: memset failed\n"); return; }
    Args a{};
    for (int i = 0; i < 25; ++i) a.in[i] = (const float*)d_in[i];
    a.out = (float*)d_out; a.ws = (unsigned char*)d_ws;
#if MK_ONE_LAUNCH
    a.lo = 0; a.hi = NPHASES;
    hipLaunchKernelGGL(mk_fwd, dim3(grid), dim3(NWAVES * 64), LDS_BYTES, stream, a);
#else
    for (int p = 0; p < NPHASES; ++p) { a.lo = p; a.hi = p + 1; hipLaunchKernelGGL(mk_fwd, dim3(grid), dim3(NWAVES * 64), LDS_BYTES, stream, a); }
#endif
    const hipError_t le = hipPeekAtLastError();
    if (le != hipSuccess) fprintf(stderr, "kernel_launch: launch failed: %s\n", hipGetErrorName(le));
}
```
